# Optimizing an MI355X kernel written in HIP

```python
import math
import jax, jax.numpy as jnp
from jax import lax
import numpy as np

D_MODEL = 1024
BATCH = 8
SEQ = 2048
DEPTH = 1

N_META = 16
BLOCK = 128
WINDOW = 128
PAD_FRONT = BLOCK - N_META

ATTN_HEADS = 8
ATTN_KV_HEADS = 2
HEAD_DIM = 64
ROPE_THETA = 10000.0
ATTN_Q_W = ATTN_HEADS * HEAD_DIM
ATTN_KV_W = ATTN_KV_HEADS * HEAD_DIM

GLA_HEADS = 4
GLA_KEY_DIM = 64
GLA_VAL_DIM = 128
GLA_K_W = GLA_HEADS * GLA_KEY_DIM
GLA_V_W = GLA_HEADS * GLA_VAL_DIM
GLA_GATE_RANK = 16
GLA_GATE_NORM = 16.0
GLA_CHUNK = 64

N_GROUPS = 4
EXPERTS_PER_GROUP = 8
EXPERT_TOP_K = 2
EXPERT_FF = 256

NORM_EPS = 1e-6
MASK_VALUE = -1e30

IN_WIDTHS = (ATTN_Q_W, ATTN_KV_W, ATTN_KV_W,
             GLA_K_W, GLA_K_W, GLA_V_W, GLA_V_W,
             GLA_GATE_RANK,
             D_MODEL, D_MODEL)
IN_TOTAL = sum(IN_WIDTHS)

kernel_name = "hybrid_swa_sink_gla_hmoe_meta"


def rms_norm(x, w):
    xf = x.astype(jnp.float32)
    y = xf * lax.rsqrt(jnp.mean(xf * xf, axis=-1, keepdims=True) + NORM_EPS)
    return (y * w.astype(jnp.float32)).astype(x.dtype)


def rope(x, pos):
    half = HEAD_DIM // 2
    inv_freq = ROPE_THETA ** (-(jnp.arange(half, dtype=jnp.float32) * 2.0) / HEAD_DIM)
    ang = pos.astype(jnp.float32)[:, None] * inv_freq[None, :]
    cos = jnp.cos(ang)[None, :, None, :]
    sin = jnp.sin(ang)[None, :, None, :]
    xf = x.astype(jnp.float32)
    x1, x2 = xf[..., :half], xf[..., half:]
    return jnp.concatenate([x1 * cos - x2 * sin, x2 * cos + x1 * sin], axis=-1).astype(x.dtype)


def swa_with_sinks(q, k, v, sinks):
    B, T = q.shape[0], q.shape[1]
    nb = T // BLOCK
    G = ATTN_HEADS // ATTN_KV_HEADS
    qb = q.reshape(B, nb, BLOCK, ATTN_KV_HEADS, G, HEAD_DIM)
    kb = k.reshape(B, nb, BLOCK, ATTN_KV_HEADS, HEAD_DIM)
    vb = v.reshape(B, nb, BLOCK, ATTN_KV_HEADS, HEAD_DIM)
    pad5 = ((0, 0), (1, 0), (0, 0), (0, 0), (0, 0))
    k_band = jnp.concatenate([jnp.pad(kb, pad5)[:, :-1], kb], axis=2)
    v_band = jnp.concatenate([jnp.pad(vb, pad5)[:, :-1], vb], axis=2)
    k_meta = k[:, PAD_FRONT:BLOCK]
    v_meta = v[:, PAD_FRONT:BLOCK]
    scale = 1.0 / math.sqrt(HEAD_DIM)
    s_band = jnp.einsum('bnqhgd,bnkhd->bnhgqk', qb, k_band).astype(jnp.float32) * scale
    s_meta = jnp.einsum('bnqhgd,bmhd->bnhgqm', qb, k_meta).astype(jnp.float32) * scale
    q_idx = jnp.arange(nb)[:, None] * BLOCK + jnp.arange(BLOCK)[None, :]
    k_idx = (jnp.arange(nb)[:, None] - 1) * BLOCK + jnp.arange(2 * BLOCK)[None, :]
    dq = q_idx[:, :, None] - k_idx[:, None, :]
    band_ok = (dq >= 0) & (dq < WINDOW) & (k_idx[:, None, :] >= BLOCK)
    meta_idx = PAD_FRONT + jnp.arange(N_META)
    meta_ok = meta_idx[None, None, :] <= q_idx[:, :, None]
    s_band = jnp.where(band_ok[None, :, None, None], s_band, MASK_VALUE)
    s_meta = jnp.where(meta_ok[None, :, None, None], s_meta, MASK_VALUE)
    sink = jnp.broadcast_to(sinks.astype(jnp.float32).reshape(1, 1, ATTN_KV_HEADS, G, 1, 1),
                            s_meta.shape[:-1] + (1,))
    p = jax.nn.softmax(jnp.concatenate([s_meta, s_band, sink], axis=-1), axis=-1)
    p_meta = p[..., :N_META].astype(v.dtype)
    p_band = p[..., N_META:N_META + 2 * BLOCK].astype(v.dtype)
    o = (jnp.einsum('bnhgqk,bnkhd->bnqhgd', p_band, v_band)
         + jnp.einsum('bnhgqm,bmhd->bnqhgd', p_meta, v_meta))
    return o.reshape(B, T, ATTN_Q_W)


def gla_chunked(q, k, v, gk):
    B, T, H, DK = q.shape
    DV = v.shape[-1]
    n = T // GLA_CHUNK
    def chunks(a):
        return a.astype(jnp.float32).reshape(B, n, GLA_CHUNK, H, a.shape[-1]).transpose(0, 3, 1, 2, 4)
    qc = chunks(q) * (DK ** -0.5)
    kc, vc, gc = chunks(k), chunks(v), chunks(gk)
    b = jnp.cumsum(gc, axis=-2)
    b_mid = b[..., GLA_CHUNK // 2:GLA_CHUNK // 2 + 1, :]
    b_last = b[..., -1:, :]
    att = jnp.einsum('bhnid,bhnjd->bhnij', qc * jnp.exp(b - b_mid), kc * jnp.exp(b_mid - b))
    causal = jnp.tril(jnp.ones((GLA_CHUNK, GLA_CHUNK), dtype=bool))
    att = jnp.where(causal, att, 0.0)
    o_intra = jnp.einsum('bhnij,bhnjv->bhniv', att, vc)
    chunk_kv = jnp.einsum('bhnjd,bhnjv->nbhdv', kc * jnp.exp(b_last - b), vc)
    chunk_decay = jnp.exp(b_last[..., 0, :]).transpose(2, 0, 1, 3)
    def step(state, inp):
        kv, dec = inp
        return dec[..., None] * state + kv, state
    _, states = lax.scan(step, jnp.zeros((B, H, DK, DV), jnp.float32), (chunk_kv, chunk_decay))
    o_inter = jnp.einsum('bhnid,nbhdv->bhniv', qc * jnp.exp(b), states)
    o = (o_intra + o_inter).transpose(0, 2, 3, 1, 4).reshape(B, T, H, DV)
    return o.astype(v.dtype)


def hier_moe(xn, router_group, router_expert, w_gate, w_up, w_down):
    xf = xn.astype(jnp.float32)
    g_logits = xf @ router_group.astype(jnp.float32)
    g_prob = jax.nn.softmax(g_logits, axis=-1)
    g_idx = jnp.argmax(g_logits, axis=-1)
    g_w = jnp.take_along_axis(g_prob, g_idx[:, None], axis=-1)
    e_logits_all = jnp.einsum('nd,gde->nge', xf, router_expert.astype(jnp.float32))
    e_logits = jnp.take_along_axis(e_logits_all, g_idx[:, None, None], axis=1)[:, 0]
    top_v, top_i = lax.top_k(e_logits, EXPERT_TOP_K)
    top_p = jax.nn.softmax(top_v, axis=-1) * g_w
    e_w = jnp.sum(jax.nn.one_hot(top_i, EXPERTS_PER_GROUP, dtype=jnp.float32) * top_p[..., None], axis=1)
    combine = (jax.nn.one_hot(g_idx, N_GROUPS, dtype=jnp.float32)[:, :, None] * e_w[:, None, :]).astype(xn.dtype)
    y = jnp.zeros_like(xn)
    for g in range(N_GROUPS):
        hg = jax.nn.silu(jnp.einsum('nd,edf->nef', xn, w_gate[g])) * jnp.einsum('nd,edf->nef', xn, w_up[g])
        y = y + jnp.einsum('nef,efd->nd', hg * combine[:, g, :, None], w_down[g])
    return y


def hybrid_layer(h, valid, pos, norm1_w, w_in, q_norm_w, k_norm_w, attn_sinks, gla_gate_up,
                 gla_gate_bias, gla_norm_w, w_attn_branch, w_gla_branch, w_out, norm2_w,
                 router_group, router_expert, expert_w_gate, expert_w_up, expert_w_down):
    B, T, D = h.shape
    xn = rms_norm(h, norm1_w)
    proj = xn @ w_in
    parts = []
    off = 0
    for w in IN_WIDTHS:
        parts.append(proj[..., off:off + w])
        off += w
    qa, ka, va, qg, kg, vg, rg, gdown, gate_a, gate_g = parts
    qa = rope(rms_norm(qa.reshape(B, T, ATTN_HEADS, HEAD_DIM), q_norm_w), pos)
    ka = rope(rms_norm(ka.reshape(B, T, ATTN_KV_HEADS, HEAD_DIM), k_norm_w), pos)
    va = va.reshape(B, T, ATTN_KV_HEADS, HEAD_DIM)
    y_attn = swa_with_sinks(qa, ka, va, attn_sinks) @ w_attn_branch
    gk = jax.nn.log_sigmoid((gdown @ gla_gate_up + gla_gate_bias).astype(jnp.float32)) / GLA_GATE_NORM
    gk = gk.reshape(B, T, GLA_HEADS, GLA_KEY_DIM)
    kg = kg.reshape(B, T, GLA_HEADS, GLA_KEY_DIM) * valid[None, :, None, None]
    og = gla_chunked(qg.reshape(B, T, GLA_HEADS, GLA_KEY_DIM), kg,
                     vg.reshape(B, T, GLA_HEADS, GLA_VAL_DIM), gk)
    og = rms_norm(og, gla_norm_w) * jax.nn.silu(rg.reshape(B, T, GLA_HEADS, GLA_VAL_DIM))
    y_gla = og.reshape(B, T, GLA_V_W) @ w_gla_branch
    merged = jax.nn.sigmoid(gate_a) * y_attn + jax.nn.sigmoid(gate_g) * y_gla
    h = h + (merged @ w_out) * valid[None, :, None]
    xn2 = rms_norm(h, norm2_w).reshape(B * T, D)
    y_ffn = hier_moe(xn2, router_group, router_expert, expert_w_gate, expert_w_up, expert_w_down)
    return h + y_ffn.reshape(B, T, D) * valid[None, :, None]


def setup_inputs(seed: int = 0) -> dict:
    key = jax.random.key(seed)
    ks = jax.random.split(key, 20)
    f32 = jnp.float32
    def nrm(k, shape, scale):
        return jax.random.normal(k, shape, f32) * scale
    L = DEPTH
    E = EXPERTS_PER_GROUP
    return {
        "x": nrm(ks[0], (BATCH, SEQ, D_MODEL), 1.0),
        "meta_tokens": nrm(ks[1], (N_META, D_MODEL), 1.0),
        "norm1_w": 1.0 + nrm(ks[2], (L, D_MODEL), 0.02),
        "w_in": nrm(ks[3], (L, D_MODEL, IN_TOTAL), D_MODEL ** -0.5),
        "q_norm_w": 1.0 + nrm(ks[4], (L, HEAD_DIM), 0.02),
        "k_norm_w": 1.0 + nrm(ks[5], (L, HEAD_DIM), 0.02),
        "attn_sinks": nrm(ks[6], (L, ATTN_HEADS), 0.5),
        "gla_gate_up": nrm(ks[7], (L, GLA_GATE_RANK, GLA_K_W), GLA_GATE_RANK ** -0.5),
        "gla_gate_bias": nrm(ks[8], (L, GLA_K_W), 0.02),
        "gla_norm_w": 1.0 + nrm(ks[9], (L, GLA_VAL_DIM), 0.02),
        "w_attn_branch": nrm(ks[10], (L, ATTN_Q_W, D_MODEL), ATTN_Q_W ** -0.5),
        "w_gla_branch": nrm(ks[11], (L, GLA_V_W, D_MODEL), GLA_V_W ** -0.5),
        "w_out": nrm(ks[12], (L, D_MODEL, D_MODEL), D_MODEL ** -0.5),
        "norm2_w": 1.0 + nrm(ks[13], (L, D_MODEL), 0.02),
        "router_group": nrm(ks[14], (L, D_MODEL, N_GROUPS), D_MODEL ** -0.5),
        "router_expert": nrm(ks[15], (L, N_GROUPS, D_MODEL, E), D_MODEL ** -0.5),
        "expert_w_gate": nrm(ks[16], (L, N_GROUPS, E, D_MODEL, EXPERT_FF), D_MODEL ** -0.5),
        "expert_w_up": nrm(ks[17], (L, N_GROUPS, E, D_MODEL, EXPERT_FF), D_MODEL ** -0.5),
        "expert_w_down": nrm(ks[18], (L, N_GROUPS, E, EXPERT_FF, D_MODEL), EXPERT_FF ** -0.5),
    }


def reference(x, meta_tokens, norm1_w, w_in, q_norm_w, k_norm_w, attn_sinks, gla_gate_up,
              gla_gate_bias, gla_norm_w, w_attn_branch, w_gla_branch, w_out, norm2_w,
              router_group, router_expert, expert_w_gate, expert_w_up, expert_w_down):
    B, S, D = x.shape
    meta = jnp.broadcast_to(meta_tokens.astype(x.dtype)[None], (B, N_META, D))
    h = jnp.concatenate([jnp.zeros((B, PAD_FRONT, D), x.dtype), meta, x], axis=1)
    T = h.shape[1]
    idx = jnp.arange(T)
    valid = (idx >= PAD_FRONT).astype(x.dtype)
    pos = idx - PAD_FRONT
    for l in range(DEPTH):
        h = hybrid_layer(h, valid, pos, norm1_w[l], w_in[l], q_norm_w[l], k_norm_w[l],
                         attn_sinks[l], gla_gate_up[l], gla_gate_bias[l], gla_norm_w[l],
                         w_attn_branch[l], w_gla_branch[l], w_out[l], norm2_w[l],
                         router_group[l], router_expert[l], expert_w_gate[l],
                         expert_w_up[l], expert_w_down[l])
    return h[:, BLOCK:]
```

```cpp
#include <hip/hip_runtime.h>
#include <stdint.h>
#include <cstdio>

namespace cfg {
constexpr int D = 1024, NB = 8, S = 2048, NMETA = 16, BLK = 128, PADF = 112, T = S + BLK;
constexpr int M = NB * S;
constexpr int MX = M + 256;
constexpr int AH = 8, AKV = 2, HD = 64;
constexpr int GH = 4, GDK = 64, GDV = 128, GR = 16, CH = 64;
constexpr int NG = 4, EPG = 8, FF = 256, NE = NG * EPG;
constexpr int INTOT = 4368;
constexpr int OFF_QA = 0, OFF_KA = 512, OFF_VA = 640, OFF_QG = 768, OFF_KG = 1024, OFF_VG = 1280, OFF_RG = 1792, OFF_GD = 2304, OFF_GA = 2320, OFF_GG = 3344;
constexpr float EPS = 1e-6f;
constexpr int NP = 4608;
constexpr int NPOS = S + NMETA;
}
using namespace cfg;

typedef unsigned short bf16_t;
#define GAS __attribute__((address_space(1)))
#define LAS __attribute__((address_space(3)))
typedef unsigned v4u __attribute__((ext_vector_type(4)));
typedef unsigned v2u __attribute__((ext_vector_type(2)));
typedef float f32x4 __attribute__((ext_vector_type(4)));
typedef float f32x16 __attribute__((ext_vector_type(16)));
typedef short bf16x8 __attribute__((ext_vector_type(8)));
typedef short bf16x4 __attribute__((ext_vector_type(4)));
typedef GAS unsigned gu32;
#define RLX_AGENT __ATOMIC_RELAXED, __HIP_MEMORY_SCOPE_AGENT
#define LDS_WAIT() asm volatile("s_waitcnt lgkmcnt(0)" ::: "memory")
#define VM_WAIT() asm volatile("s_waitcnt vmcnt(0)" ::: "memory")

constexpr size_t MiB = 1u << 20;
constexpr size_t WS_CTL  = 0;
constexpr size_t CTL_ZERO_BYTES = 1 * MiB;
constexpr size_t WS_ROPE = 1 * MiB;
constexpr size_t WS_WBT  = 2 * MiB;
constexpr size_t WS_WOT  = 4 * MiB;
constexpr size_t WS_WGU  = 6 * MiB;
constexpr size_t WS_WD   = 38 * MiB;
constexpr size_t WS_R1   = 54 * MiB;
constexpr size_t WS_R2   = WS_R1 + (size_t)MX * 1024 * 2;
constexpr size_t WS_QA   = WS_R2 + (size_t)NP * 1024 * 2;
constexpr size_t WS_VG   = WS_QA + (size_t)M * 512 * 2;
constexpr size_t WS_KA   = WS_VG + (size_t)MX * 512 * 2;
constexpr size_t WS_VA   = WS_KA + (size_t)MX * 128 * 2;
constexpr size_t WS_QG   = WS_VA + (size_t)MX * 128 * 2;
constexpr size_t WS_KG   = WS_QG + (size_t)M * 256 * 2;
constexpr size_t WS_RG   = WS_KG + (size_t)MX * 256 * 2;
constexpr size_t WS_GK   = WS_RG + (size_t)M * 512 * 2;
constexpr size_t WS_ATT  = WS_GK + (size_t)MX * 256 * 4;
constexpr size_t WS_OG   = WS_ATT + (size_t)M * 512 * 2;
constexpr size_t WS_KV   = WS_OG;
constexpr size_t WS_ST   = WS_KV + (size_t)1028 * 8192 * 4;
constexpr size_t WS_DEC  = WS_ST + (size_t)1024 * 8192 * 2;
constexpr size_t WS_END  = WS_DEC + (size_t)1028 * 64 * 4;
constexpr size_t WS_MG   = WS_QA;
constexpr size_t WS_T1   = WS_R1;
constexpr size_t WS_OI   = WS_R1;
constexpr size_t WS_XN   = WS_R1;
constexpr size_t WS_WPT  = WS_R2;
constexpr size_t WS_QH   = WS_R2;
static_assert(WS_END <= 256 * MiB, "d_ws map");
static_assert(WS_QA + (size_t)M * 1024 * 2 <= WS_KA, "MERGED overlays QA|VG only");

__device__ __forceinline__ float bf2f(bf16_t v) { return __builtin_bit_cast(float, (unsigned)v << 16); }
__device__ __forceinline__ unsigned f2bf(float f) { unsigned u = __builtin_bit_cast(unsigned, f); return (u + 0x7fffu + ((u >> 16) & 1u)) >> 16; }
__device__ __forceinline__ unsigned pk2(float lo, float hi) { return f2bf(lo) | (f2bf(hi) << 16); }
__device__ __forceinline__ float fast_sigmoid(float z) { return __builtin_amdgcn_rcpf(1.f + __expf(-z)); }
__device__ __forceinline__ float log_sigmoid_f(float z) { return fminf(z, 0.f) - log1pf(expf(-fabsf(z))); }
__device__ __forceinline__ float sigmoid_f(float z) { return 1.f / (1.f + expf(-z)); }
__device__ __forceinline__ float silu_f(float z) { return z / (1.f + expf(-z)); }
namespace pg8 {
#define PG8_LAS __attribute__((address_space(3)))
typedef unsigned short bf16_t;
typedef short bf16x8 __attribute__((ext_vector_type(8)));
typedef float f32x4 __attribute__((ext_vector_type(4)));
typedef unsigned u32x4 __attribute__((ext_vector_type(4)));
constexpr int BM = 256, BK = 64, HALF = 128, HTB = HALF * BK * 2  , STAGE_BYTES = 8 * HTB, NXCD = 8, WGM = 8;

__host__ __device__ __forceinline__ int lds_byte(int r, int c) { const int st = (r >> 4) * 2 + (c >> 5), rr = r & 15, cc = c & 31, ob = rr * 64 + cc * 2; return st * 1024 + (ob ^ (((ob >> 9) & 1) << 5)); }
__host__ __device__ __forceinline__ void stage_rc(int b, int& R, int& C) { const int st = b / 1024, sb = b % 1024, swz = sb ^ (((sb >> 9) & 1) << 5); R = (st >> 1) * 16 + swz / 64; C = (st & 1) * 32 + (swz % 64) / 2; }
__host__ __device__ __forceinline__ int perm32(int rho) { const int n = rho >> 4, i = rho & 15; return 8 * (i >> 2) + 4 * n + (i & 3); }

struct Unit { int pm, pn; };
struct Gemm { const bf16_t* A; const bf16_t* Bt; int M, N, K; };

struct StaticOrder {
    int nM, nN, nwg, G, c;
    __host__ __device__ void init(int M, int N, int G_, int c_) { nM = M / BM; nN = N / BM; nwg = nM * nN; G = G_; c = c_; }
    __host__ __device__ bool next(int i, Unit& u) const {
        const long L = (long)i * G + c; if (L >= nwg) return false;
        int wgid = (int)L; { const int q = nwg / NXCD, r = nwg % NXCD, xcd = wgid % NXCD, off = wgid / NXCD; wgid = (xcd < r ? xcd * (q + 1) : r * (q + 1) + (xcd - r) * q) + off; }
        const int nig = WGM * nN, gid = wgid / nig, fm = gid * WGM, gsz = (nM - fm) < WGM ? (nM - fm) : WGM;
        u.pm = fm + ((wgid % nig) % gsz); u.pn = (wgid % nig) / gsz; return true;
    }
    __device__ __forceinline__ void a_ready(const Unit&) const {}
    __device__ __forceinline__ void done(const Unit&) const {}
};

__device__ __forceinline__ unsigned cvt_pk_bf16(float lo, float hi) { unsigned r; asm volatile("v_cvt_pk_bf16_f32 %0, %1, %2" : "=v"(r) : "v"(lo), "v"(hi)); return r; }
struct ProjOrder {
    int G, c;
    __device__ bool next(int i, Unit& u) const {
        const int L = i * G + c; constexpr int nwg = 64 * 18;
        if (L >= nwg + 5) return false;
        if (L >= nwg) { const int k = L - nwg; u.pm = 64; u.pn = (k == 0) ? 2 : (k == 1) ? 4 : (k == 2) ? 5 : (k == 3) ? 6 : 9; return true; }
        const int q = nwg / NXCD, xcd = L % NXCD, off = L / NXCD; const int wgid = xcd * q + off;
        const int nig = WGM * 18, gid = wgid / nig, fm = gid * WGM;
        u.pm = fm + ((wgid % nig) % WGM); u.pn = (wgid % nig) / WGM; return true;
    }
    __device__ __forceinline__ void a_ready(const Unit&) const {}
    __device__ __forceinline__ void done(const Unit&) const {}
};
struct BranchOrder {
    int c;
    __device__ bool next(int i, Unit& u) const {
        if (i >= 2) return false;
        constexpr int nwg = 256; const int q = nwg / NXCD, xcd = c % NXCD, off = c / NXCD; const int wgid = xcd * q + off;
        const int nig = WGM * 4, gid = wgid / nig, fm = gid * WGM;
        u.pm = fm + ((wgid % nig) % WGM) + 64 * i; u.pn = (wgid % nig) / WGM + 4 * i; return true;
    }
    __device__ __forceinline__ void a_ready(const Unit&) const {}
    __device__ __forceinline__ void done(const Unit&) const {}
};

__device__ __forceinline__ v4u pack8(const f32x4& a, const f32x4& b) { v4u w; w.x = cvt_pk_bf16(a[0], a[1]); w.y = cvt_pk_bf16(a[2], a[3]); w.z = cvt_pk_bf16(b[0], b[1]); w.w = cvt_pk_bf16(b[2], b[3]); return w; }
__device__ __forceinline__ void unpack8(const v4u& w, f32x4& a, f32x4& b) {
    a[0] = __builtin_bit_cast(float, w.x << 16); a[1] = __builtin_bit_cast(float, w.x & 0xffff0000u); a[2] = __builtin_bit_cast(float, w.y << 16); a[3] = __builtin_bit_cast(float, w.y & 0xffff0000u);
    b[0] = __builtin_bit_cast(float, w.z << 16); b[1] = __builtin_bit_cast(float, w.z & 0xffff0000u); b[2] = __builtin_bit_cast(float, w.w << 16); b[3] = __builtin_bit_cast(float, w.w & 0xffff0000u);
}

struct EpiProj {
    static constexpr bool PERM = true, AFTER_DRAIN = false;
    bf16_t *QA, *KA, *VA, *QG, *KG, *VG, *RG, *SA, *SG; float* GK;
    const float *qnw, *knw, *gbias; const float* rope;
    __device__ __forceinline__ void operator()(const f32x4 (&acc)[2][2][4][2], const Unit& u, int wr, int wc, int fr, int fq) const {
        const int pn = u.pn; const int row0 = u.pm * BM + wr * 64 + fr;
        if (pn < 2 || (pn == 2 && wc < 2)) {
            const bool isq = pn < 2; const int head = isq ? pn * 4 + wc : wc; const float* nw = isq ? qnw : knw; bf16_t* dst = isq ? QA : KA; const int ldd = isq ? 512 : 128;
            const float osc = isq ? 0.125f : 1.0f;
            const f32x4 w1a = *(const f32x4*)(nw + 8 * fq), w1b = *(const f32x4*)(nw + 8 * fq + 4), w2a = *(const f32x4*)(nw + 32 + 8 * fq), w2b = *(const f32x4*)(nw + 32 + 8 * fq + 4);
#pragma unroll
            for (int ai = 0; ai < 2; ++ai)
#pragma unroll
                for (int m = 0; m < 4; ++m) {
                    const int row = row0 + ai * HALF + m * 16;
                    f32x4 x1a = acc[ai][0][m][0], x1b = acc[ai][0][m][1], x2a = acc[ai][1][m][0], x2b = acc[ai][1][m][1];
                    float ss = 0.f;
#pragma unroll
                    for (int j = 0; j < 4; ++j) ss += x1a[j] * x1a[j] + x1b[j] * x1b[j] + x2a[j] * x2a[j] + x2b[j] * x2b[j];
                    ss += __shfl_xor(ss, 16); ss += __shfl_xor(ss, 32);
                    const float r = rsqrtf(ss * (1.0f / 64.0f) + EPS) * osc;
                    const int pos = (row < M) ? (row & (S - 1)) + NMETA : (row - M);
                    const float* rp = rope + ((size_t)pos * 32 + 8 * fq) * 2;
                    const f32x4 cs0 = *(const f32x4*)(rp), cs1 = *(const f32x4*)(rp + 4), cs2 = *(const f32x4*)(rp + 8), cs3 = *(const f32x4*)(rp + 12);
                    x1a = x1a * w1a * r; x1b = x1b * w1b * r; x2a = x2a * w2a * r; x2b = x2b * w2b * r;
                    f32x4 o1a, o1b, o2a, o2b;
                    o1a[0] = x1a[0] * cs0[0] - x2a[0] * cs0[1]; o2a[0] = x2a[0] * cs0[0] + x1a[0] * cs0[1];
                    o1a[1] = x1a[1] * cs0[2] - x2a[1] * cs0[3]; o2a[1] = x2a[1] * cs0[2] + x1a[1] * cs0[3];
                    o1a[2] = x1a[2] * cs1[0] - x2a[2] * cs1[1]; o2a[2] = x2a[2] * cs1[0] + x1a[2] * cs1[1];
                    o1a[3] = x1a[3] * cs1[2] - x2a[3] * cs1[3]; o2a[3] = x2a[3] * cs1[2] + x1a[3] * cs1[3];
                    o1b[0] = x1b[0] * cs2[0] - x2b[0] * cs2[1]; o2b[0] = x2b[0] * cs2[0] + x1b[0] * cs2[1];
                    o1b[1] = x1b[1] * cs2[2] - x2b[1] * cs2[3]; o2b[1] = x2b[1] * cs2[2] + x1b[1] * cs2[3];
                    o1b[2] = x1b[2] * cs3[0] - x2b[2] * cs3[1]; o2b[2] = x2b[2] * cs3[0] + x1b[2] * cs3[1];
                    o1b[3] = x1b[3] * cs3[2] - x2b[3] * cs3[3]; o2b[3] = x2b[3] * cs3[2] + x1b[3] * cs3[3];
                    bf16_t* rowp = dst + (size_t)row * ldd + head * 64 + 8 * fq;
                    *(v4u*)(rowp) = pack8(o1a, o1b); *(v4u*)(rowp + 32) = pack8(o2a, o2b);
                }
            return;
        }
        if (pn == 2) {
#pragma unroll
            for (int ai = 0; ai < 2; ++ai)
#pragma unroll
                for (int m = 0; m < 4; ++m) { const int row = row0 + ai * HALF + m * 16; bf16_t* rowp = VA + (size_t)row * 128 + (wc - 2) * 64 + 8 * fq;
#pragma unroll
                    for (int bj = 0; bj < 2; ++bj) *(v4u*)(rowp + 32 * bj) = pack8(acc[ai][bj][m][0], acc[ai][bj][m][1]); }
            return;
        }
        const int ct = wc * 32 + 8 * fq;
        if (pn == 9) {
#pragma unroll
            for (int bj = 0; bj < 2; ++bj) { const int col = ct + bj * HALF; const f32x4 b0 = *(const f32x4*)(gbias + col), b1 = *(const f32x4*)(gbias + col + 4);
#pragma unroll
                for (int ai = 0; ai < 2; ++ai)
#pragma unroll
                    for (int m = 0; m < 4; ++m) { const int row = row0 + ai * HALF + m * 16; f32x4 z0 = acc[ai][bj][m][0] + b0, z1 = acc[ai][bj][m][1] + b1;
#pragma unroll
                        for (int j = 0; j < 4; ++j) { z0[j] = (fminf(z0[j], 0.f) - __logf(1.f + __expf(-fabsf(z0[j])))) * 0.0625f; z1[j] = (fminf(z1[j], 0.f) - __logf(1.f + __expf(-fabsf(z1[j])))) * 0.0625f; }
                        float* rowp = GK + (size_t)row * 256 + col; *(f32x4*)rowp = z0; *(f32x4*)(rowp + 4) = z1; } }
            return;
        }
        bf16_t* dst; int ldd, cbase, act; float sc = 1.f;
        if (pn == 3) { dst = QG; ldd = 256; cbase = 0; act = 0; sc = 0.125f; }
        else if (pn == 4) { dst = KG; ldd = 256; cbase = 0; act = 0; }
        else if (pn < 7) { dst = VG; ldd = 512; cbase = (pn - 5) * 256; act = 0; }
        else if (pn < 9) { dst = RG; ldd = 512; cbase = (pn - 7) * 256; act = 1; }
        else if (pn < 14) { dst = SA; ldd = 1024; cbase = (pn - 10) * 256; act = 2; }
        else { dst = SG; ldd = 1024; cbase = (pn - 14) * 256; act = 2; }
#pragma unroll
        for (int ai = 0; ai < 2; ++ai)
#pragma unroll
            for (int m = 0; m < 4; ++m) { const int row = row0 + ai * HALF + m * 16; bf16_t* rowp = dst + (size_t)row * ldd + cbase + ct;
#pragma unroll
                for (int bj = 0; bj < 2; ++bj) { f32x4 v0 = acc[ai][bj][m][0] * sc, v1 = acc[ai][bj][m][1] * sc;
                    if (act != 0) {
#pragma unroll
                        for (int j = 0; j < 4; ++j) { const float s0 = fast_sigmoid(v0[j]), s1 = fast_sigmoid(v1[j]); v0[j] = (act == 1) ? v0[j] * s0 : s0; v1[j] = (act == 1) ? v1[j] * s1 : s1; } }
                    *(v4u*)(rowp + bj * HALF) = pack8(v0, v1); } }
    }
};

struct EpiBranch {
    static constexpr bool PERM = true, AFTER_DRAIN = false;
    const bf16_t *SA, *SG; bf16_t *T1, *MG;
    __device__ __forceinline__ void operator()(const f32x4 (&acc)[2][2][4][2], const Unit& u, int wr, int wc, int fr, int fq) const {
        const bool second = u.pm >= 64; const int pm = u.pm & 63, pn = u.pn & 3;
        const int row0 = pm * BM + wr * 64 + fr, col0 = pn * BM + wc * 32 + 8 * fq;
        const bf16_t* G = second ? SG : SA;
#pragma unroll
        for (int ai = 0; ai < 2; ++ai)
#pragma unroll
            for (int m = 0; m < 4; ++m) { const size_t off = (size_t)(row0 + ai * HALF + m * 16) * 1024 + col0;
#pragma unroll
                for (int bj = 0; bj < 2; ++bj) { f32x4 g0, g1; unpack8(*(const v4u*)(G + off + bj * HALF), g0, g1);
                    f32x4 v0 = acc[ai][bj][m][0] * g0, v1 = acc[ai][bj][m][1] * g1;
                    if (second) { f32x4 t0, t1; unpack8(*(const v4u*)(T1 + off + bj * HALF), t0, t1); v0 = v0 + t0; v1 = v1 + t1; *(v4u*)(MG + off + bj * HALF) = pack8(v0, v1); }
                    else *(v4u*)(T1 + off + bj * HALF) = pack8(v0, v1); } }
    }
};

struct EpiOut {
    static constexpr bool PERM = false, AFTER_DRAIN = false;
    const float* X; float* O;
    __device__ __forceinline__ void operator()(const f32x4 (&acc)[2][2][4][2], const Unit& u, int wr, int wc, int fr, int fq) const {
        const int row0 = u.pm * BM + wr * 64 + fr, col0 = u.pn * BM + wc * 32 + 4 * fq;
#pragma unroll
        for (int ai = 0; ai < 2; ++ai)
#pragma unroll
            for (int m = 0; m < 4; ++m) { const size_t off = (size_t)(row0 + ai * HALF + m * 16) * 1024 + col0;
#pragma unroll
                for (int bj = 0; bj < 2; ++bj)
#pragma unroll
                    for (int n = 0; n < 2; ++n) { const f32x4 xv = *(const f32x4*)(X + off + bj * HALF + n * 16); *(f32x4*)(O + off + bj * HALF + n * 16) = xv + acc[ai][bj][m][n]; } }
    }
};
template <class Epi, class Sched, bool ALIGN_EPI = false, bool SP2 = false>
__device__ __forceinline__ void gemm_phase(PG8_LAS unsigned char* lds, const Gemm g, const Sched& S, const Epi& E) {
    const int tid = threadIdx.x, wid = __builtin_amdgcn_readfirstlane(tid >> 6), lane = tid & 63, wr = wid >> 2, wc = wid & 3, fr = lane & 15, fq = lane >> 4;
    const int K = g.K, nt = K / BK;
    unsigned voffA[2], voffB[2];
#pragma unroll
    for (int i = 0; i < 2; ++i) { int R, C; stage_rc(tid * 16 + i * 8192, R, C); const int Rb = Epi::PERM ? ((R & ~31) + perm32(R & 31)) : R;
        voffA[i] = (unsigned)(R * K + C) * 2u; voffB[i] = (unsigned)(Rb * K + C) * 2u; }
    const size_t kstep = (size_t)(BK * 2);
    const size_t hstep = (size_t)HALF * K * 2;
    const size_t tstep = 2 * hstep;
    const unsigned ldsw = (unsigned)wid * 1024u;
    const int aoff = lds_byte(wr * 64 + fr, fq * 8), boff = lds_byte(wc * 32 + fr, fq * 8);
#define PG8_SA(b, h) (((b) * 2 + (h)) * HTB)
#define PG8_SB(b, h) ((4 + (b) * 2 + (h)) * HTB)
#define PG8_STAGE(bufoff, gbase, voff) do { _Pragma("unroll") for (int _i = 0; _i < 2; ++_i) \
        __builtin_amdgcn_global_load_lds((const unsigned*)((const char*)(gbase) + (voff)[_i]), (PG8_LAS unsigned*)(lds + (bufoff) + ldsw + _i * 8192), 16, 0, 0); } while (0)
#define PG8_LDA(dst, b, h) do { _Pragma("unroll") for (int m = 0; m < 4; ++m) _Pragma("unroll") for (int k = 0; k < 2; ++k) dst[m][k] = *(const PG8_LAS bf16x8*)(lds + PG8_SA(b, h) + aoff + m * 2048 + k * 1024); } while (0)
#define PG8_LDB(dst, b, h) do { _Pragma("unroll") for (int n = 0; n < 2; ++n) _Pragma("unroll") for (int k = 0; k < 2; ++k) dst[n][k] = *(const PG8_LAS bf16x8*)(lds + PG8_SB(b, h) + boff + n * 2048 + k * 1024); } while (0)
#define PG8_MMA(ai, bj, At, Bt) do { __builtin_amdgcn_s_setprio(1); _Pragma("unroll") for (int m = 0; m < 4; ++m) _Pragma("unroll") for (int n = 0; n < 2; ++n) _Pragma("unroll") for (int k = 0; k < 2; ++k) \
        acc[ai][bj][m][n] = __builtin_amdgcn_mfma_f32_16x16x32_bf16(Bt[n][k], At[m][k], acc[ai][bj][m][n], 0, 0, 0); __builtin_amdgcn_s_setprio(0); } while (0)
#define PG8_WAIT_V(n) asm volatile("s_waitcnt vmcnt(" #n ")" ::: "memory")
#define PG8_WAIT_L(n) asm volatile("s_waitcnt lgkmcnt(" #n ")" ::: "memory")
#define PG8_BAR __builtin_amdgcn_s_barrier()
#define PG8_SCHED __builtin_amdgcn_sched_barrier(0)
    Unit cur, nxt; int ui = 0;
    if (!S.next(0, cur)) return;
    f32x4 acc[2][2][4][2];
#pragma unroll
    for (int a = 0; a < 2; ++a)
#pragma unroll
        for (int b = 0; b < 2; ++b)
#pragma unroll
            for (int m = 0; m < 4; ++m)
#pragma unroll
                for (int n = 0; n < 2; ++n) acc[a][b][m][n] = (f32x4){0.f, 0.f, 0.f, 0.f};
    bf16x8 At[4][2], B0[2][2], B1[2][2];
    const char* cA = (const char*)g.A + (size_t)cur.pm * tstep; const char* cB = (const char*)g.Bt + (size_t)cur.pn * tstep;
    S.a_ready(cur);
    if constexpr (SP2) {
        PG8_STAGE(PG8_SB(0, 0), cB, voffB); PG8_STAGE(PG8_SB(0, 1), cB + hstep, voffB); PG8_STAGE(PG8_SA(0, 0), cA, voffA); PG8_STAGE(PG8_SA(0, 1), cA + hstep, voffA);
        if (wr == 1) PG8_BAR;
        PG8_WAIT_V(2); PG8_BAR;
        PG8_STAGE(PG8_SB(1, 0), cB + kstep, voffB); PG8_STAGE(PG8_SA(1, 0), cA + kstep, voffA); PG8_STAGE(PG8_SB(1, 1), cB + hstep + kstep, voffB);
        PG8_WAIT_V(6); PG8_BAR;
    } else {
        PG8_STAGE(PG8_SB(0, 0), cB, voffB); PG8_STAGE(PG8_SA(0, 0), cA, voffA); PG8_STAGE(PG8_SB(0, 1), cB + hstep, voffB); PG8_STAGE(PG8_SA(0, 1), cA + hstep, voffA);
        if (wr == 1) PG8_BAR;
        PG8_WAIT_V(4); PG8_BAR;
        PG8_STAGE(PG8_SB(1, 0), cB + kstep, voffB); PG8_STAGE(PG8_SA(1, 0), cA + kstep, voffA); PG8_STAGE(PG8_SB(1, 1), cB + hstep + kstep, voffB);
        PG8_WAIT_V(6); PG8_BAR;
    }
    for (;;) {
        const bool has_next = S.next(ui + 1, nxt);
        const char* nA = has_next ? (const char*)g.A + (size_t)nxt.pm * tstep : cA; const char* nB = has_next ? (const char*)g.Bt + (size_t)nxt.pn * tstep : cB;
        for (int t = 0; t < nt; t += 2) {
            const bool last = (t == nt - 2);
            const char* a1 = cA + (size_t)(t + 1) * kstep;
            const char* a2 = last ? nA : cA + (size_t)(t + 2) * kstep; const char* b2 = last ? nB : cB + (size_t)(t + 2) * kstep;
            const char* a3 = a2 + kstep; const char* b3 = b2 + kstep;
            if (last && has_next) S.a_ready(nxt);
            if constexpr (SP2) {
            PG8_LDB(B0, 0, 0); PG8_LDB(B1, 0, 1); PG8_SCHED; PG8_LDA(At, 0, 0); PG8_STAGE(PG8_SA(1, 1), a1 + hstep, voffA);
            PG8_WAIT_V(8); PG8_WAIT_L(0); PG8_BAR; PG8_MMA(0, 0, At, B0); PG8_MMA(0, 1, At, B1); PG8_BAR; PG8_SCHED;
            PG8_LDA(At, 0, 1); PG8_STAGE(PG8_SB(0, 0), b2, voffB); PG8_STAGE(PG8_SB(0, 1), b2 + hstep, voffB); PG8_STAGE(PG8_SA(0, 0), a2, voffA);
            PG8_WAIT_V(8); PG8_WAIT_L(0); PG8_BAR; PG8_MMA(1, 0, At, B0); PG8_MMA(1, 1, At, B1); PG8_BAR; PG8_SCHED;
            PG8_LDB(B0, 1, 0); PG8_LDB(B1, 1, 1); PG8_SCHED; PG8_LDA(At, 1, 0); PG8_STAGE(PG8_SA(0, 1), a2 + hstep, voffA);
            PG8_WAIT_V(8); PG8_WAIT_L(0); PG8_BAR; PG8_MMA(0, 0, At, B0); PG8_MMA(0, 1, At, B1); PG8_BAR; PG8_SCHED;
            PG8_LDA(At, 1, 1); PG8_STAGE(PG8_SB(1, 0), b3, voffB); PG8_STAGE(PG8_SB(1, 1), b3 + hstep, voffB); PG8_STAGE(PG8_SA(1, 0), a3, voffA);
            PG8_WAIT_V(8); PG8_WAIT_L(0); PG8_BAR; PG8_MMA(1, 0, At, B0); PG8_MMA(1, 1, At, B1); PG8_BAR; PG8_SCHED;
            } else {
            PG8_LDB(B0, 0, 0); PG8_SCHED; PG8_LDA(At, 0, 0); PG8_STAGE(PG8_SA(1, 1), a1 + hstep, voffA);
            PG8_WAIT_L(8); PG8_BAR; PG8_WAIT_L(0); PG8_MMA(0, 0, At, B0); PG8_BAR; PG8_SCHED;
            PG8_LDB(B1, 0, 1); PG8_STAGE(PG8_SB(0, 0), b2, voffB);
            PG8_BAR; PG8_WAIT_L(0); PG8_MMA(0, 1, At, B1); PG8_BAR;
            PG8_LDA(At, 0, 1); PG8_STAGE(PG8_SA(0, 0), a2, voffA);
            PG8_BAR; PG8_WAIT_L(0); PG8_MMA(1, 0, At, B0); PG8_BAR; PG8_SCHED;
            PG8_STAGE(PG8_SB(0, 1), b2 + hstep, voffB);
            PG8_WAIT_V(6); PG8_BAR; PG8_MMA(1, 1, At, B1); PG8_BAR;
            PG8_LDB(B0, 1, 0); PG8_SCHED; PG8_LDA(At, 1, 0); PG8_STAGE(PG8_SA(0, 1), a2 + hstep, voffA);
            PG8_WAIT_L(8); PG8_BAR; PG8_WAIT_L(0); PG8_MMA(0, 0, At, B0); PG8_BAR; PG8_SCHED;
            PG8_LDB(B1, 1, 1); PG8_STAGE(PG8_SB(1, 0), b3, voffB);
            PG8_BAR; PG8_WAIT_L(0); PG8_MMA(0, 1, At, B1); PG8_BAR;
            PG8_LDA(At, 1, 1); PG8_STAGE(PG8_SA(1, 0), a3, voffA);
            PG8_BAR; PG8_WAIT_L(0); PG8_MMA(1, 0, At, B0); PG8_BAR; PG8_SCHED;
            PG8_STAGE(PG8_SB(1, 1), b3 + hstep, voffB);
            PG8_WAIT_V(6); PG8_BAR; PG8_MMA(1, 1, At, B1); PG8_BAR;
            }
        }
        if constexpr (ALIGN_EPI) { if (wr == 0) PG8_BAR; }
        if constexpr (!Epi::AFTER_DRAIN) { E(acc, cur, wr, wc, fr, fq); S.done(cur); }
        if (!has_next) break;
#pragma unroll
        for (int a = 0; a < 2; ++a)
#pragma unroll
            for (int b = 0; b < 2; ++b)
#pragma unroll
                for (int m = 0; m < 4; ++m)
#pragma unroll
                    for (int n = 0; n < 2; ++n) acc[a][b][m][n] = (f32x4){0.f, 0.f, 0.f, 0.f};
        cur = nxt; cA = nA; cB = nB; ++ui;
        if constexpr (ALIGN_EPI) { if (wr == 1) PG8_BAR; }
    }
    PG8_WAIT_V(0);
    if constexpr (!ALIGN_EPI) { if (wr == 0) PG8_BAR; }
    PG8_BAR;
    if constexpr (Epi::AFTER_DRAIN) { E.fused(acc, cur, wr, wc, fr, fq, lds, wid, lane); S.done(cur); }
#undef PG8_SA
#undef PG8_SB
#undef PG8_STAGE
#undef PG8_LDA
#undef PG8_LDB
#undef PG8_MMA
#undef PG8_WAIT_V
#undef PG8_WAIT_L
#undef PG8_BAR
#undef PG8_SCHED
}
}
#define XB_TMO      128
#define XB_XCNT(j)  (256  + 64 * (j))
#define XB_XSUB(j)  (1280 + 64 * (j))
#define XB_XGEN(j)  (2304 + 64 * (j))
#define XB_TOP      3328
#define XB_TOPGEN   3392
#define XCD_BAR_WORDS 3456
#define XB_SPIN_CAP (1u << 18)

__device__ __forceinline__ unsigned xb_ld(unsigned* p)              { return __hip_atomic_load(p, __ATOMIC_RELAXED, __HIP_MEMORY_SCOPE_AGENT); }
__device__ __forceinline__ unsigned xb_add(unsigned* p, unsigned v) { return __hip_atomic_fetch_add(p, v, __ATOMIC_RELAXED, __HIP_MEMORY_SCOPE_AGENT); }
__device__ __forceinline__ unsigned xb_xcc_id() { return (unsigned)__builtin_amdgcn_s_getreg((3 << 11) | 20) & 0xFu; }
#define XB_SPIN(cond, bar) do { unsigned _sp = 0; while (cond) { __builtin_amdgcn_s_sleep(1); \
    if ((++_sp & 255u) == 0u) { if (xb_ld(&(bar)[XB_TMO])) break; if (_sp > XB_SPIN_CAP) { atomicAdd(&(bar)[XB_TMO], 1u); break; } } } } while (0)

struct XcdBarrier {
    unsigned* bar; unsigned x;
    volatile LAS unsigned* st;
};

__device__ __forceinline__ XcdBarrier xcd_barrier_post(unsigned* bar, volatile LAS unsigned* st) {
    XcdBarrier b; b.bar = bar; b.x = xb_xcc_id(); b.st = st;
    if (threadIdx.x == 0) (void)xb_add(&bar[XB_XCNT(b.x)], 1u);
    return b;
}
__device__ __forceinline__ void xcd_barrier_complete(unsigned* bar, unsigned x, unsigned& nloc, unsigned& nx) {
    const unsigned G = gridDim.x * gridDim.y * gridDim.z;
    unsigned sum, cnt, mine, sp = 0u;
    for (;;) {
        sum = 0u; cnt = 0u; mine = 0u;
#pragma unroll
        for (unsigned j = 0; j < 16; ++j) { const unsigned c = xb_ld(&bar[XB_XCNT(j)]); sum += c; cnt += (c > 0u) ? 1u : 0u; mine = (j == x) ? c : mine; }
        if (sum == G) break;
        __builtin_amdgcn_s_sleep(1);
        if ((++sp & 255u) == 0u) { if (xb_ld(&bar[XB_TMO])) break; if (sp > XB_SPIN_CAP) { atomicAdd(&bar[XB_TMO], 1u); break; } }
    }
    nloc = mine > 0u ? mine : 1u; nx = cnt > 0u ? cnt : 1u;
}

__device__ __forceinline__ void xcd_barrier(const XcdBarrier& b) {
    asm volatile("s_waitcnt vmcnt(0)" ::: "memory");
    __syncthreads();
    if (threadIdx.x == 0) {
        unsigned* bar = b.bar;
        __builtin_amdgcn_s_waitcnt(0);
        unsigned nloc = b.st[0], nx = b.st[1];
        if (nloc == 0u) { xcd_barrier_complete(bar, b.x, nloc, nx); b.st[0] = nloc; b.st[1] = nx; }
        const unsigned old = xb_add(&bar[XB_XSUB(b.x)], 1u);
        const unsigned gen = old / nloc;
        if (old + 1u == (gen + 1u) * nloc) {
            __builtin_amdgcn_fence(__ATOMIC_RELEASE, "agent");
            asm volatile("s_waitcnt vmcnt(0)" ::: "memory");
            const unsigned og = xb_add(&bar[XB_TOP], 1u);
            const unsigned tg = og / nx;
            if (og + 1u == (tg + 1u) * nx) xb_add(&bar[XB_TOPGEN], 1u);
            else XB_SPIN(xb_ld(&bar[XB_TOPGEN]) == tg, bar);
            __builtin_amdgcn_fence(__ATOMIC_ACQUIRE, "agent");
            xb_add(&bar[XB_XGEN(b.x)], 1u);
            asm volatile("s_waitcnt vmcnt(0)" ::: "memory");
        } else {
            XB_SPIN(xb_ld(&bar[XB_XGEN(b.x)]) == gen, bar);
            __builtin_amdgcn_fence(__ATOMIC_ACQUIRE, "agent");
            asm volatile("s_waitcnt vmcnt(0)" ::: "memory");
        }
    }
    __syncthreads();
}
constexpr int NWAVES = 8;
constexpr int RING_OFF = 0, RING_BYTES = 131072;
constexpr int LDSCTL_OFF = RING_BYTES, MISC_OFF = LDSCTL_OFF + 320;
constexpr int LDS_BYTES = 147456;
constexpr int CW_TMO = 0, CW_CODE = 1, CW_BAR = 4096;

struct Frame {
    LAS unsigned char* lds;
    volatile LAS unsigned* MISC;
    gu32* ctl;
    int tid, lane, wave, vcu, G;
    const float *x, *meta, *norm1_w, *w_in, *q_norm_w, *k_norm_w, *sinks, *gate_up, *gate_bias, *gla_norm_w, *w_ab, *w_gb, *w_out, *norm2_w, *r_g, *r_e, *e_wg, *e_wu, *e_wd;
    float* out; unsigned char* ws;
};

__device__ __forceinline__ float wave_sum(float v) {
#pragma unroll
    for (int o = 1; o < 64; o <<= 1) v += __shfl_xor(v, o);
    return v;
}

__device__ __forceinline__ void p0_tr_item(const float* W, int ld, int scol0, bf16_t* WT, int Kdst, int drow0, int k0, LAS float* scr, int lane) {
#pragma unroll 8
    for (int i = 0; i < 32; ++i) { const int kk = 2 * i + (lane >> 5); scr[kk * 33 + (lane & 31)] = W[(size_t)(k0 + kk) * ld + scol0 + (lane & 31)]; }
    LDS_WAIT(); asm volatile("" ::: "memory");
    const int c = lane & 7;
#pragma unroll
    for (int j = 0; j < 4; ++j) { const int n = (lane >> 3) + 8 * j; const LAS float* s = scr + (8 * c) * 33 + n;
        v4u o; o.x = pk2(s[0 * 33], s[1 * 33]); o.y = pk2(s[2 * 33], s[3 * 33]); o.z = pk2(s[4 * 33], s[5 * 33]); o.w = pk2(s[6 * 33], s[7 * 33]);
        *(GAS v4u*)(WT + (size_t)(drow0 + n) * Kdst + k0 + 8 * c) = o; }
    LDS_WAIT(); asm volatile("" ::: "memory");
}
__device__ __forceinline__ void p0_gk_item(const float* w_in, const float* gate_up, int c0, bf16_t* WT, int drow0, int k0, LAS float* scr, int lane) {
#pragma unroll 4
    for (int i = 0; i < 32; ++i) { const int kk = 2 * i + (lane >> 5); const float* wr = w_in + (size_t)(k0 + kk) * INTOT + OFF_GD; float a = 0.f;
#pragma unroll
        for (int r = 0; r < GR; ++r) a += wr[r] * gate_up[r * 256 + c0 + (lane & 31)];
        scr[kk * 33 + (lane & 31)] = a; }
    LDS_WAIT(); asm volatile("" ::: "memory");
    const int c = lane & 7;
#pragma unroll
    for (int j = 0; j < 4; ++j) { const int n = (lane >> 3) + 8 * j; const LAS float* s = scr + (8 * c) * 33 + n;
        v4u o; o.x = pk2(s[0 * 33], s[1 * 33]); o.y = pk2(s[2 * 33], s[3 * 33]); o.z = pk2(s[4 * 33], s[5 * 33]); o.w = pk2(s[6 * 33], s[7 * 33]);
        *(GAS v4u*)(WT + (size_t)(drow0 + n) * 1024 + k0 + 8 * c) = o; }
    LDS_WAIT(); asm volatile("" ::: "memory");
}
__device__ __forceinline__ int wpt_src_col(int n0) {
    const int tile = n0 >> 8, c = n0 & 255, bj = c >> 7, wc = (c & 127) >> 5;
    if (tile < 2) return OFF_QA + (tile * 4 + wc) * 64 + 32 * bj;
    if (tile == 2) return (wc < 2) ? OFF_KA + wc * 64 + 32 * bj : OFF_VA + (wc - 2) * 64 + 32 * bj;
    if (tile == 3) return OFF_QG + c;
    if (tile == 4) return OFF_KG + c;
    if (tile < 7) return OFF_VG + (tile - 5) * 256 + c;
    if (tile < 9) return OFF_RG + (tile - 7) * 256 + c;
    if (tile == 9) return -1;
    if (tile < 14) return OFF_GA + (tile - 10) * 256 + c;
    return OFF_GG + (tile - 14) * 256 + c;
}
__device__ __forceinline__ void rms_row_to_bf16(const float* xrow, const float* w, bf16_t* orow, int lane) {
    const GAS f32x4* xr = (const GAS f32x4*)xrow + lane; const GAS f32x4* wr = (const GAS f32x4*)w + lane;
    f32x4 v[4]; float s = 0.f;
#pragma unroll
    for (int j = 0; j < 4; ++j) { v[j] = xr[64 * j]; s += (v[j].x * v[j].x + v[j].y * v[j].y) + (v[j].z * v[j].z + v[j].w * v[j].w); }
    const float rstd = rsqrtf(wave_sum(s) * (1.f / D) + EPS);
    GAS unsigned long long* o8 = (GAS unsigned long long*)orow + lane;
#pragma unroll
    for (int j = 0; j < 4; ++j) { const f32x4 ww = wr[64 * j];
        o8[64 * j] = (unsigned long long)pk2(v[j].x * rstd * ww.x, v[j].y * rstd * ww.y) | ((unsigned long long)pk2(v[j].z * rstd * ww.z, v[j].w * rstd * ww.w) << 32); }
}
__device__ __forceinline__ void p0_prologue(Frame& F) {
    LAS float* scr = (LAS float*)(F.lds + RING_OFF + F.wave * 16384);
    const int gw = F.vcu * NWAVES + F.wave, NGW = F.G * NWAVES;
    bf16_t* WpT = (bf16_t*)(F.ws + WS_WPT); bf16_t* WbT = (bf16_t*)(F.ws + WS_WBT); bf16_t* WoT = (bf16_t*)(F.ws + WS_WOT);
    bf16_t* Wgu = (bf16_t*)(F.ws + WS_WGU); bf16_t* Wd = (bf16_t*)(F.ws + WS_WD); bf16_t* XN = (bf16_t*)(F.ws + WS_XN);
    constexpr int I_P = 16 * (NP / 32), I_B = 8 * 32, I_O = 16 * 32, I_GU = NE * 16 * 16, I_D = NE * 4 * 32;
    constexpr int NITEMS = I_P + 2 * I_B + I_O + I_GU + I_D;
    for (int it = gw; it < NITEMS; it += NGW) {
        int r = it;
        if (r < I_P) { const int nb = r >> 4, kb = r & 15, sc = wpt_src_col(nb * 32);
            if (sc >= 0) p0_tr_item(F.w_in, INTOT, sc, WpT, 1024, nb * 32, kb * 64, scr, F.lane);
            else p0_gk_item(F.w_in, F.gate_up, (nb * 32) & 255, WpT, nb * 32, kb * 64, scr, F.lane);
            continue; } r -= I_P;
        if (r < I_B) { p0_tr_item(F.w_ab, 1024, (r >> 3) * 32, WbT, 512, (r >> 3) * 32, (r & 7) * 64, scr, F.lane); continue; } r -= I_B;
        if (r < I_B) { p0_tr_item(F.w_gb, 1024, (r >> 3) * 32, WbT, 512, 1024 + (r >> 3) * 32, (r & 7) * 64, scr, F.lane); continue; } r -= I_B;
        if (r < I_O) { p0_tr_item(F.w_out, 1024, (r >> 4) * 32, WoT, 1024, (r >> 4) * 32, (r & 15) * 64, scr, F.lane); continue; } r -= I_O;
        if (r < I_GU) { const int ge = r >> 8, q = r & 255, nb = q >> 4, kb = q & 15;
            const int tn = nb >> 3, bj = (nb >> 2) & 1, qq = nb & 3;
            p0_tr_item((bj ? F.e_wu : F.e_wg) + (size_t)ge * D * FF, FF, tn * 128 + qq * 32, Wgu + (size_t)ge * 512 * 1024, 1024, nb * 32, kb * 64, scr, F.lane); continue; } r -= I_GU;
        { const int ge = r >> 7, q = r & 127, nb = q >> 2, kb = q & 3;
            p0_tr_item(F.e_wd + (size_t)ge * FF * D, D, nb * 32, Wd + (size_t)ge * 1024 * 256, 256, nb * 32, kb * 64, scr, F.lane); }
    }
    for (int m = gw; m < MX; m += NGW) {
        bf16_t* orow = XN + (size_t)m * D;
        if (m < M) rms_row_to_bf16(F.x + (size_t)m * D, F.norm1_w, orow, F.lane);
        else if (m < M + NMETA) rms_row_to_bf16(F.meta + (size_t)(m - M) * D, F.norm1_w, orow, F.lane);
        else { GAS v4u* o = (GAS v4u*)orow + F.lane; o[0] = (v4u){0u, 0u, 0u, 0u}; o[64] = (v4u){0u, 0u, 0u, 0u}; }
    }
    float* rope = (float*)(F.ws + WS_ROPE);
    for (int e = (F.vcu * NWAVES * 64) + F.tid; e < NPOS * 32; e += F.G * NWAVES * 64) {
        const int pos = e >> 5, i = e & 31; const float inv_freq = powf(10000.0f, -((float)(2 * i)) / 64.0f); const float ang = (float)pos * inv_freq;
        rope[2 * e] = cosf(ang); rope[2 * e + 1] = sinf(ang); }
}
__device__ __forceinline__ bool attn_valid(int kt, int kr, int i, int qb) {
    if (kt == 0) return kr < 16;
    if (kt < 5) return (qb > 0) && (32 * (kt - 1) + kr > i);
    return 32 * (kt - 5) + kr <= i;
}
__device__ __forceinline__ bool attn_skip(int kt, int i0, int qb) {
    if (kt == 0) return false;
    if (kt < 5) return (qb == 0) || (32 * (kt - 1) + 31 <= i0);
    return 32 * (kt - 5) > i0 + 31;
}
__device__ __forceinline__ void attn_phase(Frame& F) {
    constexpr int KSTR = 144, VSTR = 584;
    LAS unsigned char* Ks = F.lds + RING_OFF; LAS unsigned char* Vt = F.lds + RING_OFF + 288 * KSTR;
    const bf16_t* QA = (const bf16_t*)(F.ws + WS_QA); const bf16_t* KA = (const bf16_t*)(F.ws + WS_KA); const bf16_t* VA = (const bf16_t*)(F.ws + WS_VA); bf16_t* ATT = (bf16_t*)(F.ws + WS_ATT);
    const int lane = F.lane, l31 = lane & 31, hh = lane >> 5;
    for (int u = blockIdx.x; u < 256; u += F.G) {
        const int b = u >> 5, kvh = (u >> 4) & 1, qb = u & 15, m0 = b * S + qb * 128;
        for (int idx = F.tid; idx < 288 * 8; idx += NWAVES * 64) {
            const int slot = idx >> 3, ch = idx & 7;
            int row = -1;
            if (slot < 16) row = M + slot; else if (slot >= 160) row = m0 + (slot - 160); else if (slot >= 32 && qb > 0) row = m0 - 128 + (slot - 32);
            v4u kv = (v4u){0u, 0u, 0u, 0u}, vv = (v4u){0u, 0u, 0u, 0u};
            if (row >= 0) { kv = *(const v4u*)(KA + (size_t)row * 128 + kvh * 64 + ch * 8); vv = *(const v4u*)(VA + (size_t)row * 128 + kvh * 64 + ch * 8); }
            *(LAS v4u*)(Ks + slot * KSTR + ch * 16) = kv;
#pragma unroll
            for (int e = 0; e < 8; ++e) { const unsigned w = vv[e >> 1]; *(LAS unsigned short*)(Vt + (8 * ch + e) * VSTR + slot * 2) = (unsigned short)((e & 1) ? (w >> 16) : (w & 0xffffu)); }
        }
        __syncthreads();
        const int g = F.wave >> 1, qh = F.wave & 1, head = kvh * 4 + g;
        const float sink = F.sinks[head];
#pragma unroll 1
        for (int blk = 0; blk < 2; ++blk) {
            const int i0 = 64 * qh + 32 * blk, i = i0 + l31;
            bf16x8 qf[4];
#pragma unroll
            for (int ds = 0; ds < 4; ++ds) qf[ds] = *(const bf16x8*)(QA + (size_t)(m0 + i) * 512 + head * 64 + 16 * ds + 8 * hh);
            float mx = -1e30f;
#pragma unroll
            for (int kt = 0; kt < 9; ++kt) {
                if (attn_skip(kt, i0, qb)) continue;
                f32x16 s = {0.f, 0.f, 0.f, 0.f, 0.f, 0.f, 0.f, 0.f, 0.f, 0.f, 0.f, 0.f, 0.f, 0.f, 0.f, 0.f};
#pragma unroll
                for (int ds = 0; ds < 4; ++ds) { const bf16x8 kf = *(const LAS bf16x8*)(Ks + (32 * kt + l31) * KSTR + (16 * ds + 8 * hh) * 2); s = __builtin_amdgcn_mfma_f32_32x32x16_bf16(kf, qf[ds], s, 0, 0, 0); }
#pragma unroll
                for (int r = 0; r < 16; ++r) { const int kr = (r & 3) + 8 * (r >> 2) + 4 * hh; if (attn_valid(kt, kr, i, qb)) mx = fmaxf(mx, s[r]); }
            }
            mx = fmaxf(mx, __shfl_xor(mx, 32)); mx = fmaxf(mx, sink);
            float lsum = 0.f;
            f32x16 o0 = {0.f, 0.f, 0.f, 0.f, 0.f, 0.f, 0.f, 0.f, 0.f, 0.f, 0.f, 0.f, 0.f, 0.f, 0.f, 0.f}, o1 = o0;
#pragma unroll
            for (int kt = 0; kt < 9; ++kt) {
                if (attn_skip(kt, i0, qb)) continue;
                f32x16 s = {0.f, 0.f, 0.f, 0.f, 0.f, 0.f, 0.f, 0.f, 0.f, 0.f, 0.f, 0.f, 0.f, 0.f, 0.f, 0.f};
#pragma unroll
                for (int ds = 0; ds < 4; ++ds) { const bf16x8 kf = *(const LAS bf16x8*)(Ks + (32 * kt + l31) * KSTR + (16 * ds + 8 * hh) * 2); s = __builtin_amdgcn_mfma_f32_32x32x16_bf16(kf, qf[ds], s, 0, 0, 0); }
                float p[16];
#pragma unroll
                for (int r = 0; r < 16; ++r) { const int kr = (r & 3) + 8 * (r >> 2) + 4 * hh; p[r] = attn_valid(kt, kr, i, qb) ? __expf(s[r] - mx) : 0.f; lsum += p[r]; }
#pragma unroll
                for (int s2 = 0; s2 < 2; ++s2) {
                    v4u pw; pw.x = pg8::cvt_pk_bf16(p[8 * s2 + 0], p[8 * s2 + 1]); pw.y = pg8::cvt_pk_bf16(p[8 * s2 + 2], p[8 * s2 + 3]); pw.z = pg8::cvt_pk_bf16(p[8 * s2 + 4], p[8 * s2 + 5]); pw.w = pg8::cvt_pk_bf16(p[8 * s2 + 6], p[8 * s2 + 7]);
                    const bf16x8 pf = __builtin_bit_cast(bf16x8, pw);
#pragma unroll
                    for (int dt = 0; dt < 2; ++dt) {
                        const LAS unsigned char* vp = Vt + (32 * dt + l31) * VSTR + (32 * kt + 16 * s2 + 4 * hh) * 2;
                        const v2u lo = *(const LAS v2u*)vp, hi = *(const LAS v2u*)(vp + 16);
                        const bf16x8 vf = __builtin_bit_cast(bf16x8, (v4u){lo.x, lo.y, hi.x, hi.y});
                        if (dt == 0) o0 = __builtin_amdgcn_mfma_f32_32x32x16_bf16(vf, pf, o0, 0, 0, 0); else o1 = __builtin_amdgcn_mfma_f32_32x32x16_bf16(vf, pf, o1, 0, 0, 0);
                    }
                }
            }
            lsum += __shfl_xor(lsum, 32); lsum += __expf(sink - mx);
            const float inv = 1.0f / lsum;
            bf16_t* orow = ATT + (size_t)(m0 + i) * 512 + head * 64 + 4 * hh;
#pragma unroll
            for (int rq = 0; rq < 4; ++rq) {
                v2u w0, w1;
                w0.x = pg8::cvt_pk_bf16(o0[4 * rq] * inv, o0[4 * rq + 1] * inv); w0.y = pg8::cvt_pk_bf16(o0[4 * rq + 2] * inv, o0[4 * rq + 3] * inv);
                w1.x = pg8::cvt_pk_bf16(o1[4 * rq] * inv, o1[4 * rq + 1] * inv); w1.y = pg8::cvt_pk_bf16(o1[4 * rq + 2] * inv, o1[4 * rq + 3] * inv);
                *(v2u*)(orow + 8 * rq) = w0; *(v2u*)(orow + 32 + 8 * rq) = w1;
            }
        }
        __syncthreads();
    }
}
__device__ __forceinline__ int crow16(int r, int hh) { return (r & 3) + 8 * (r >> 2) + 4 * hh; }
__device__ __forceinline__ void gla_a_unit(Frame& F, int unit) {
    constexpr int STR = 144;
    LAS unsigned char* Qt = F.lds + RING_OFF; LAS unsigned char* Kt = Qt + 64 * STR; LAS unsigned char* KhT = Kt + 64 * STR; LAS unsigned char* VtT = KhT + 64 * STR;
    LAS float* segsum = (LAS float*)(VtT + 128 * STR); LAS float* gmid = segsum + 512;
    const float* GK = (const float*)(F.ws + WS_GK); const bf16_t* QG = (const bf16_t*)(F.ws + WS_QG); const bf16_t* KG = (const bf16_t*)(F.ws + WS_KG); const bf16_t* VG = (const bf16_t*)(F.ws + WS_VG);
    bf16_t* QH = (bf16_t*)(F.ws + WS_QH); float* OI = (float*)(F.ws + WS_OI); float* KV = (float*)(F.ws + WS_KV); float* DEC = (float*)(F.ws + WS_DEC);
    const bool meta = unit >= 1024; const int bh = meta ? 0 : (unit >> 5), c = unit & 31, h = meta ? (unit - 1024) : (bh & 3), b = bh >> 2;
    const int r0 = meta ? (M - 48) : (b * S + 64 * c);
    const int tid = F.tid, d = tid & 63, seg = tid >> 6, lane = F.lane, l31 = lane & 31, hh = lane >> 5;
    float g[8], bb[8]; float run = 0.f;
#pragma unroll
    for (int j = 0; j < 8; ++j) { const int t = 8 * seg + j; const bool ok = !meta || t >= 48; g[j] = ok ? GK[(size_t)(r0 + t) * 256 + h * 64 + d] : 0.f; run += g[j]; bb[j] = run; }
    segsum[seg * 64 + d] = run; if (seg == 4) gmid[d] = g[0];
    for (int idx = tid; idx < 1024; idx += NWAVES * 64) { const int t = idx >> 4, ch = idx & 15; const bool ok = !meta || t >= 48;
        v4u vv = (v4u){0u, 0u, 0u, 0u}; if (ok) vv = *(const v4u*)(VG + (size_t)(r0 + t) * 512 + h * 128 + ch * 8);
#pragma unroll
        for (int e = 0; e < 8; ++e) { const unsigned w = vv[e >> 1]; *(LAS unsigned short*)(VtT + (8 * ch + e) * STR + t * 2) = (unsigned short)((e & 1) ? (w >> 16) : (w & 0xffffu)); } }
    __syncthreads();
    float off = 0.f, tot = 0.f, hsum = 0.f;
#pragma unroll
    for (int s = 0; s < 8; ++s) { const float v = segsum[s * 64 + d]; if (s < seg) off += v; if (s < 4) hsum += v; tot += v; }
    const float bmid = hsum + gmid[d], blast = tot;
#pragma unroll
    for (int j = 0; j < 8; ++j) { const int t = 8 * seg + j; const bool ok = !meta || t >= 48; const float bt = off + bb[j];
        const float q = (ok && !meta) ? bf2f(QG[(size_t)(r0 + t) * 256 + h * 64 + d]) : 0.f, k = ok ? bf2f(KG[(size_t)(r0 + t) * 256 + h * 64 + d]) : 0.f;
        *(LAS unsigned short*)(Qt + t * STR + d * 2) = (unsigned short)f2bf(q * __expf(bt - bmid));
        *(LAS unsigned short*)(Kt + t * STR + d * 2) = (unsigned short)f2bf(k * __expf(bmid - bt));
        *(LAS unsigned short*)(KhT + d * STR + t * 2) = (unsigned short)f2bf(k * __expf(blast - bt));
        if (!meta) QH[(size_t)(r0 + t) * 256 + h * 64 + d] = (bf16_t)f2bf(q * __expf(bt)); }
    if (seg == 0) DEC[(size_t)unit * 64 + d] = __expf(blast);
    __syncthreads();
    const int w = F.wave, iblk = w & 1, vt = w >> 1;
    if (!meta) {
        f32x16 oacc = {0.f, 0.f, 0.f, 0.f, 0.f, 0.f, 0.f, 0.f, 0.f, 0.f, 0.f, 0.f, 0.f, 0.f, 0.f, 0.f};
#pragma unroll
        for (int jt = 0; jt < 2; ++jt) {
            if (jt > iblk) continue;
            f32x16 a = {0.f, 0.f, 0.f, 0.f, 0.f, 0.f, 0.f, 0.f, 0.f, 0.f, 0.f, 0.f, 0.f, 0.f, 0.f, 0.f};
#pragma unroll
            for (int ds = 0; ds < 4; ++ds) { const bf16x8 kf = *(const LAS bf16x8*)(Kt + (32 * jt + l31) * STR + (16 * ds + 8 * hh) * 2), qf = *(const LAS bf16x8*)(Qt + (32 * iblk + l31) * STR + (16 * ds + 8 * hh) * 2);
                a = __builtin_amdgcn_mfma_f32_32x32x16_bf16(kf, qf, a, 0, 0, 0); }
            if (jt == iblk) {
#pragma unroll
                for (int r = 0; r < 16; ++r) if (crow16(r, hh) > l31) a[r] = 0.f; }
#pragma unroll
            for (int s2 = 0; s2 < 2; ++s2) {
                v4u pw; pw.x = pg8::cvt_pk_bf16(a[8 * s2 + 0], a[8 * s2 + 1]); pw.y = pg8::cvt_pk_bf16(a[8 * s2 + 2], a[8 * s2 + 3]); pw.z = pg8::cvt_pk_bf16(a[8 * s2 + 4], a[8 * s2 + 5]); pw.w = pg8::cvt_pk_bf16(a[8 * s2 + 6], a[8 * s2 + 7]);
                const LAS unsigned char* vp = VtT + (32 * vt + l31) * STR + (32 * jt + 16 * s2 + 4 * hh) * 2;
                const v2u lo = *(const LAS v2u*)vp, hi = *(const LAS v2u*)(vp + 16);
                oacc = __builtin_amdgcn_mfma_f32_32x32x16_bf16(__builtin_bit_cast(bf16x8, (v4u){lo.x, lo.y, hi.x, hi.y}), __builtin_bit_cast(bf16x8, pw), oacc, 0, 0, 0);
            }
        }
        float* op = OI + ((size_t)unit * 8 + w) * 1024 + lane;
#pragma unroll
        for (int r = 0; r < 16; ++r) op[r * 64] = oacc[r];
    }
    {
        const int dblk = w & 1;
        f32x16 kv = {0.f, 0.f, 0.f, 0.f, 0.f, 0.f, 0.f, 0.f, 0.f, 0.f, 0.f, 0.f, 0.f, 0.f, 0.f, 0.f};
#pragma unroll
        for (int s = 0; s < 4; ++s) { const bf16x8 vf = *(const LAS bf16x8*)(VtT + (32 * vt + l31) * STR + (16 * s + 8 * hh) * 2), kf = *(const LAS bf16x8*)(KhT + (32 * dblk + l31) * STR + (16 * s + 8 * hh) * 2);
            kv = __builtin_amdgcn_mfma_f32_32x32x16_bf16(vf, kf, kv, 0, 0, 0); }
        float* kp = KV + (size_t)unit * 8192 + 32 * dblk + l31;
#pragma unroll
        for (int r = 0; r < 16; ++r) kp[(32 * vt + crow16(r, hh)) * 64] = kv[r];
    }
    __syncthreads();
}
__device__ __forceinline__ void gla_scan_phase(Frame& F) {
    typedef float f32x2 __attribute__((ext_vector_type(2)));
    const float* KV = (const float*)(F.ws + WS_KV); const float* DEC = (const float*)(F.ws + WS_DEC); bf16_t* St = (bf16_t*)(F.ws + WS_ST);
    for (int e = F.vcu * NWAVES * 64 + F.tid; e < 32 * 4096; e += F.G * NWAVES * 64) {
        const int bh = e >> 12, p = e & 4095, v = p >> 5, d2 = (p & 31) * 2, h = bh & 3;
        f32x2 s = *(const f32x2*)(KV + (size_t)(1024 + h) * 8192 + v * 64 + d2);
#pragma unroll 8
        for (int c = 0; c < 32; ++c) { const size_t unit = (size_t)bh * 32 + c;
            *(unsigned*)(St + unit * 8192 + v * 64 + d2) = pk2(s.x, s.y);
            const f32x2 dec = *(const f32x2*)(DEC + unit * 64 + d2), kv = *(const f32x2*)(KV + unit * 8192 + v * 64 + d2);
            s = dec * s + kv; }
    }
}
__device__ __forceinline__ void gla_c_phase(Frame& F) {
    const bf16_t* QH = (const bf16_t*)(F.ws + WS_QH); const float* OI = (const float*)(F.ws + WS_OI); const bf16_t* St = (const bf16_t*)(F.ws + WS_ST); const bf16_t* RG = (const bf16_t*)(F.ws + WS_RG);
    bf16_t* OG = (bf16_t*)(F.ws + WS_OG);
    const int lane = F.lane, l31 = lane & 31, hh = lane >> 5, w = F.wave;
    for (int u = blockIdx.x; u < 256; u += F.G) {
        const int bh = u >> 3, cg = u & 7, b = bh >> 2, h = bh & 3, c = 4 * cg + (w >> 1), iblk = w & 1;
        const size_t unit = (size_t)bh * 32 + c; const int row = b * S + 64 * c + 32 * iblk + l31;
        bf16x8 qf[4];
#pragma unroll
        for (int s = 0; s < 4; ++s) qf[s] = *(const bf16x8*)(QH + (size_t)row * 256 + h * 64 + 16 * s + 8 * hh);
        f32x16 acc[4]; float ss = 0.f;
#pragma unroll
        for (int vt = 0; vt < 4; ++vt) {
            const float* op = OI + (unit * 8 + vt * 2 + iblk) * 1024 + lane;
#pragma unroll
            for (int r = 0; r < 16; ++r) acc[vt][r] = op[r * 64];
#pragma unroll
            for (int s = 0; s < 4; ++s) { const bf16x8 sf = *(const bf16x8*)(St + unit * 8192 + (32 * vt + l31) * 64 + 16 * s + 8 * hh); acc[vt] = __builtin_amdgcn_mfma_f32_32x32x16_bf16(sf, qf[s], acc[vt], 0, 0, 0); }
#pragma unroll
            for (int r = 0; r < 16; ++r) ss += acc[vt][r] * acc[vt][r];
        }
        ss += __shfl_xor(ss, 32);
        const float rstd = rsqrtf(ss * (1.0f / 128.0f) + EPS);
#pragma unroll
        for (int vt = 0; vt < 4; ++vt)
#pragma unroll
            for (int rq = 0; rq < 4; ++rq) { const int v0 = 32 * vt + 8 * rq + 4 * hh;
                const f32x4 w4 = *(const f32x4*)(F.gla_norm_w + v0); const v2u rg = *(const v2u*)(RG + (size_t)row * 512 + h * 128 + v0);
                const float o0 = acc[vt][4 * rq + 0] * rstd * w4[0] * __builtin_bit_cast(float, rg.x << 16), o1 = acc[vt][4 * rq + 1] * rstd * w4[1] * __builtin_bit_cast(float, rg.x & 0xffff0000u);
                const float o2 = acc[vt][4 * rq + 2] * rstd * w4[2] * __builtin_bit_cast(float, rg.y << 16), o3 = acc[vt][4 * rq + 3] * rstd * w4[3] * __builtin_bit_cast(float, rg.y & 0xffff0000u);
                v2u o; o.x = pg8::cvt_pk_bf16(o0, o1); o.y = pg8::cvt_pk_bf16(o2, o3);
                *(v2u*)(OG + (size_t)row * 512 + h * 128 + v0) = o; }
    }
}
constexpr size_t WS_WRT = WS_ROPE + 640 * 1024;
constexpr size_t WS_XN2 = WS_MG;
constexpr size_t WS_HID = WS_RG;
constexpr size_t WS_EL  = WS_GK;
constexpr size_t WS_EW  = WS_EL + 2 * MiB;
constexpr size_t WS_PL  = WS_EW + 2 * MiB;
constexpr size_t WS_TI  = WS_PL + 7 * MiB;
static_assert(WS_TI + (size_t)M * 4 <= WS_ATT, "MoE lists inside the dead GK region");
constexpr int CW_ECNT = 12288;
constexpr int LCAP = 16384;

__device__ __forceinline__ void p0_router_weights(Frame& F) {
    float* WrT = (float*)(F.ws + WS_WRT);
    for (int e = F.vcu * NWAVES * 64 + F.tid; e < 48 * 1024; e += F.G * NWAVES * 64) {
        const int n = e >> 10, d = e & 1023; float v = 0.f;
        if (n < 4) v = F.r_g[(size_t)d * NG + n]; else if (n < 36) { const int g = (n - 4) >> 3, ex = (n - 4) & 7; v = F.r_e[((size_t)g * D + d) * EPG + ex]; }
        WrT[e] = v * F.norm2_w[d]; }
}
__device__ __forceinline__ void router_phase(Frame& F) {
    LAS float* lg = (LAS float*)(F.lds + RING_OFF);
    LAS float* ssq = lg + 2 * 64 * 48;
    LAS int* hist = (LAS int*)(ssq + 128);
    LAS int* base = hist + 144;
    LAS float* rstd_s = (LAS float*)(base + 144);
    const float* WrT = (const float*)(F.ws + WS_WRT); const float* H = F.out; bf16_t* XN2 = (bf16_t*)(F.ws + WS_XN2);
    int* EL = (int*)(F.ws + WS_EL); float* EW = (float*)(F.ws + WS_EW); int* PL = (int*)(F.ws + WS_PL); int* TI = (int*)(F.ws + WS_TI);
    unsigned* gcnt = (unsigned*)(F.ctl + CW_ECNT);
    const int tid = F.tid, lane = F.lane, w = F.wave;
    for (int tile = blockIdx.x; tile < M / 64; tile += F.G) {
        const int t0 = tile * 64;
        if (tid < 144) hist[tid] = 0;
        {
            const int tg = w & 3, kh = w >> 2, tk = lane & 15, q = lane >> 4;
            const float* hp = H + (size_t)(t0 + 16 * tg + tk) * D + 512 * kh + 4 * q; const float* wp = WrT + (size_t)tk * D + 512 * kh + 4 * q;
            f32x4 a0 = {0.f, 0.f, 0.f, 0.f}, a1 = a0, a2 = a0; float ss = 0.f;
#pragma unroll 4
            for (int ks = 0; ks < 32; ++ks) {
                const f32x4 hv = *(const f32x4*)(hp + 16 * ks); ss += (hv[0] * hv[0] + hv[1] * hv[1]) + (hv[2] * hv[2] + hv[3] * hv[3]);
                const f32x4 w0 = *(const f32x4*)(wp + 16 * ks), w1 = *(const f32x4*)(wp + 16 * D + 16 * ks), w2 = *(const f32x4*)(wp + 32 * D + 16 * ks);
#pragma unroll
                for (int e = 0; e < 4; ++e) { a0 = __builtin_amdgcn_mfma_f32_16x16x4f32(w0[e], hv[e], a0, 0, 0, 0); a1 = __builtin_amdgcn_mfma_f32_16x16x4f32(w1[e], hv[e], a1, 0, 0, 0); a2 = __builtin_amdgcn_mfma_f32_16x16x4f32(w2[e], hv[e], a2, 0, 0, 0); }
            }
            ss += __shfl_xor(ss, 16); ss += __shfl_xor(ss, 32);
            LAS float* lp = lg + (kh * 64 + 16 * tg + tk) * 48 + 4 * q;
#pragma unroll
            for (int r = 0; r < 4; ++r) { lp[r] = a0[r]; lp[16 + r] = a1[r]; lp[32 + r] = a2[r]; }
            if (q == 0) ssq[kh * 64 + 16 * tg + tk] = ss;
        }
        __syncthreads();
        int ge_lo = 0, ge_hi = 0, pr = 0, rk_lo = 0, rk_hi = 0, rk_p = 0; float w_lo = 0.f, w_hi = 0.f;
        if (tid < 64) {
            const float rs = rsqrtf((ssq[tid] + ssq[64 + tid]) * (1.0f / D) + EPS); rstd_s[tid] = rs;
            const LAS float* l0 = lg + tid * 48; const LAS float* l1 = lg + (64 + tid) * 48;
            int g = 0; float mx = (l0[0] + l1[0]) * rs; float gl[4]; gl[0] = mx;
#pragma unroll
            for (int i = 1; i < 4; ++i) { gl[i] = (l0[i] + l1[i]) * rs; if (gl[i] > mx) { mx = gl[i]; g = i; } }
            float den = 0.f;
#pragma unroll
            for (int i = 0; i < 4; ++i) den += expf(gl[i] - mx);
            const float gw = 1.0f / den;
            int e1 = 0; float v1 = (l0[4 + 8 * g] + l1[4 + 8 * g]) * rs; float el[8]; el[0] = v1;
#pragma unroll
            for (int i = 1; i < 8; ++i) { el[i] = (l0[4 + 8 * g + i] + l1[4 + 8 * g + i]) * rs; if (el[i] > v1) { v1 = el[i]; e1 = i; } }
            int e2 = -1; float v2 = -3.0e38f;
#pragma unroll
            for (int i = 0; i < 8; ++i) if (i != e1 && el[i] > v2) { v2 = el[i]; e2 = i; }
            const float p2 = expf(v2 - v1), dn = 1.0f / (1.0f + p2); const float w1 = gw * dn, w2 = gw * p2 * dn;
            const int elo = e1 < e2 ? e1 : e2, ehi = e1 < e2 ? e2 : e1; w_lo = e1 < e2 ? w1 : w2; w_hi = e1 < e2 ? w2 : w1;
            ge_lo = 8 * g + elo; ge_hi = 8 * g + ehi; pr = g * 28 + (elo * (15 - elo)) / 2 + (ehi - elo - 1);
            rk_lo = atomicAdd((int*)(hist + ge_lo), 1); rk_hi = atomicAdd((int*)(hist + ge_hi), 1); rk_p = atomicAdd((int*)(hist + 32 + pr), 1);
        }
        __syncthreads();
        if (tid < 144) { const int c = hist[tid]; base[tid] = c ? (int)atomicAdd(gcnt + tid, (unsigned)c) : 0; }
        __syncthreads();
        if (tid < 64) {
            const int token = t0 + tid;
            const int plo = base[ge_lo] + rk_lo, phi = base[ge_hi] + rk_hi, pp = base[32 + pr] + rk_p;
            EL[(size_t)ge_lo * LCAP + plo] = token; EW[(size_t)ge_lo * LCAP + plo] = w_lo;
            EL[(size_t)ge_hi * LCAP + phi] = token | (1 << 16); EW[(size_t)ge_hi * LCAP + phi] = w_hi;
            PL[(size_t)pr * LCAP + pp] = token; TI[token] = ge_lo | (ge_hi << 8);
        }
        for (int i = w; i < 64; i += NWAVES) {
            const float rs = rstd_s[i]; const int token = t0 + i;
            const f32x4* xr = (const f32x4*)(H + (size_t)token * D) + lane; const f32x4* wr = (const f32x4*)F.norm2_w + lane;
            unsigned long long* o8 = (unsigned long long*)(XN2 + (size_t)token * D) + lane;
#pragma unroll
            for (int j = 0; j < 4; ++j) { const f32x4 v = xr[64 * j], ww = wr[64 * j];
                o8[64 * j] = (unsigned long long)pk2(v[0] * rs * ww[0], v[1] * rs * ww[1]) | ((unsigned long long)pk2(v[2] * rs * ww[2], v[3] * rs * ww[3]) << 32); }
        }
        __syncthreads();
    }
}
namespace mg {
constexpr int BUFB = 49152, INFO_OFF = 2 * BUFB;
template <bool PERM, class Epi>
__device__ __forceinline__ void tile(LAS unsigned char* lds, const bf16_t* A, int lda, const bf16_t* B0, const bf16_t* B1, int ksplit, int ldb, int nk, const Epi& E) {
    const int tid = threadIdx.x, wid = __builtin_amdgcn_readfirstlane(tid >> 6), lane = tid & 63, wr = wid >> 2, wc = wid & 3, fr = lane & 15, fq = lane >> 4;
    const LAS int* rows = (const LAS int*)(lds + INFO_OFF);
    unsigned aoffv[2], boffv[2];
#pragma unroll
    for (int i = 0; i < 2; ++i) { int R, C; pg8::stage_rc(tid * 16 + i * 8192, R, C); const int Rb = PERM ? ((R & ~31) + pg8::perm32(R & 31)) : R;
        aoffv[i] = (unsigned)(rows[R] * lda + C) * 2u; boffv[i] = (unsigned)(Rb * ldb + C) * 2u; }
    const unsigned ldsw = (unsigned)wid * 1024u; const size_t bhalf = (size_t)128 * ldb * 2;
    const int aoff = pg8::lds_byte(wr * 64 + fr, fq * 8), boff = pg8::lds_byte(wc * 32 + fr, fq * 8);
#define MG_STAGE(b, kt) do { const char* ap_ = (const char*)A + (size_t)(kt) * 128; const char* bp_ = ((kt) < ksplit) ? (const char*)B0 + (size_t)(kt) * 128 : (const char*)B1 + (size_t)((kt) - ksplit) * 128; \
        _Pragma("unroll") for (int i_ = 0; i_ < 2; ++i_) __builtin_amdgcn_global_load_lds((const unsigned*)(ap_ + aoffv[i_]), (LAS unsigned*)(lds + (b) * BUFB + ldsw + i_ * 8192), 16, 0, 0); \
        _Pragma("unroll") for (int h_ = 0; h_ < 2; ++h_) _Pragma("unroll") for (int i_ = 0; i_ < 2; ++i_) \
            __builtin_amdgcn_global_load_lds((const unsigned*)(bp_ + h_ * bhalf + boffv[i_]), (LAS unsigned*)(lds + (b) * BUFB + 16384 + h_ * 16384 + ldsw + i_ * 8192), 16, 0, 0); } while (0)
    f32x4 acc[2][4][2];
#pragma unroll
    for (int b = 0; b < 2; ++b)
#pragma unroll
        for (int m = 0; m < 4; ++m)
#pragma unroll
            for (int n = 0; n < 2; ++n) acc[b][m][n] = (f32x4){0.f, 0.f, 0.f, 0.f};
    MG_STAGE(0, 0);
    for (int kt = 0; kt < nk; ++kt) {
        const int cb = kt & 1;
        if (kt + 1 < nk) { MG_STAGE(cb ^ 1, kt + 1); asm volatile("s_waitcnt vmcnt(6)" ::: "memory"); } else { asm volatile("s_waitcnt vmcnt(0)" ::: "memory"); }
        __builtin_amdgcn_s_barrier(); __builtin_amdgcn_sched_barrier(0);
        bf16x8 At[4][2], Bt[2][2][2];
        const LAS unsigned char* pa = lds + cb * BUFB + aoff; const LAS unsigned char* pb = lds + cb * BUFB + 16384 + boff;
#pragma unroll
        for (int m = 0; m < 4; ++m)
#pragma unroll
            for (int k = 0; k < 2; ++k) At[m][k] = *(const LAS bf16x8*)(pa + m * 2048 + k * 1024);
#pragma unroll
        for (int bj = 0; bj < 2; ++bj)
#pragma unroll
            for (int n = 0; n < 2; ++n)
#pragma unroll
                for (int k = 0; k < 2; ++k) Bt[bj][n][k] = *(const LAS bf16x8*)(pb + bj * 16384 + n * 2048 + k * 1024);
#pragma unroll
        for (int bj = 0; bj < 2; ++bj)
#pragma unroll
            for (int m = 0; m < 4; ++m)
#pragma unroll
                for (int n = 0; n < 2; ++n)
#pragma unroll
                    for (int k = 0; k < 2; ++k) acc[bj][m][n] = __builtin_amdgcn_mfma_f32_16x16x32_bf16(Bt[bj][n][k], At[m][k], acc[bj][m][n], 0, 0, 0);
        asm volatile("s_waitcnt lgkmcnt(0)" ::: "memory");
        __builtin_amdgcn_sched_barrier(0); __builtin_amdgcn_s_barrier();
    }
#undef MG_STAGE
    E(acc, wr, wc, fr, fq);
}
}

struct EpiMoe1 {
    LAS unsigned char* lds; bf16_t* HID; int tn, nvalid;
    __device__ __forceinline__ void operator()(const f32x4 (&acc)[2][4][2], int wr, int wc, int fr, int fq) const {
        const LAS int* rows = (const LAS int*)(lds + mg::INFO_OFF); const LAS float* wts = (const LAS float*)(lds + mg::INFO_OFF + 512); const LAS int* aux = (const LAS int*)(lds + mg::INFO_OFF + 1024);
#pragma unroll
        for (int m = 0; m < 4; ++m) { const int r = wr * 64 + m * 16 + fr; if (r >= nvalid) continue;
            const float cw = wts[r]; f32x4 h0, h1;
#pragma unroll
            for (int j = 0; j < 4; ++j) { const float g0 = acc[0][m][0][j], g1 = acc[0][m][1][j]; h0[j] = g0 * fast_sigmoid(g0) * acc[1][m][0][j] * cw; h1[j] = g1 * fast_sigmoid(g1) * acc[1][m][1][j] * cw; }
            *(v4u*)(HID + (size_t)rows[r] * 512 + aux[r] * 256 + tn * 128 + wc * 32 + 8 * fq) = pg8::pack8(h0, h1); }
    }
};
struct EpiMoe2 {
    LAS unsigned char* lds; float* O; int tn, nvalid;
    __device__ __forceinline__ void operator()(const f32x4 (&acc)[2][4][2], int wr, int wc, int fr, int fq) const {
        const LAS int* rows = (const LAS int*)(lds + mg::INFO_OFF);
#pragma unroll
        for (int m = 0; m < 4; ++m) { const int r = wr * 64 + m * 16 + fr; if (r >= nvalid) continue;
            float* op = O + (size_t)rows[r] * D + tn * 256 + wc * 32 + 4 * fq;
#pragma unroll
            for (int bj = 0; bj < 2; ++bj)
#pragma unroll
                for (int n = 0; n < 2; ++n) { f32x4* p = (f32x4*)(op + bj * 128 + n * 16); *p = *p + acc[bj][m][n]; } }
    }
};
__device__ __forceinline__ void moe1_phase(Frame& F) {
    LAS unsigned char* lds = F.lds + RING_OFF;
    LAS int* pre = (LAS int*)(lds + mg::INFO_OFF + 2048);
    const unsigned* gcnt = (const unsigned*)(F.ctl + CW_ECNT);
    const int* EL = (const int*)(F.ws + WS_EL); const float* EW = (const float*)(F.ws + WS_EW);
    if (F.tid == 0) { int a = 0; for (int e = 0; e < NE; ++e) { pre[e] = a; a += (((int)gcnt[e] + 127) >> 7) * 2; } pre[NE] = a; }
    __syncthreads();
    const int total = pre[NE];
    for (int u = blockIdx.x; u < total; u += F.G) {
        int e = 0; while (e < NE - 1 && u >= pre[e + 1]) ++e;
        const int q = u - pre[e], mt = q >> 1, tn = q & 1, cnt = (int)gcnt[e], nvalid = (cnt - mt * 128 < 128) ? (cnt - mt * 128) : 128;
        __syncthreads();
        if (F.tid < 128) { const int idx = mt * 128 + ((F.tid < nvalid) ? F.tid : 0); const int ent = EL[(size_t)e * LCAP + idx];
            ((LAS int*)(lds + mg::INFO_OFF))[F.tid] = ent & 0xffff; ((LAS float*)(lds + mg::INFO_OFF + 512))[F.tid] = EW[(size_t)e * LCAP + idx]; ((LAS int*)(lds + mg::INFO_OFF + 1024))[F.tid] = ent >> 16; }
        __syncthreads();
        const bf16_t* Bp = (const bf16_t*)(F.ws + WS_WGU) + (size_t)e * 512 * 1024 + (size_t)tn * 256 * 1024;
        EpiMoe1 E{lds, (bf16_t*)(F.ws + WS_HID), tn, nvalid};
        mg::tile<true, EpiMoe1>(lds, (const bf16_t*)(F.ws + WS_XN2), D, Bp, Bp, 1 << 30, 1024, 16, E);
    }
    __syncthreads();
}
__device__ __forceinline__ void moe2_phase(Frame& F) {
    LAS unsigned char* lds = F.lds + RING_OFF;
    LAS int* pre = (LAS int*)(lds + mg::INFO_OFF + 2048);
    const unsigned* pcnt = (const unsigned*)(F.ctl + CW_ECNT) + 32;
    const int* PL = (const int*)(F.ws + WS_PL);
    if (F.tid == 0) { int a = 0; for (int p = 0; p < 112; ++p) { pre[p] = a; a += (((int)pcnt[p] + 127) >> 7) * 4; } pre[112] = a; }
    __syncthreads();
    const int total = pre[112];
    for (int u = blockIdx.x; u < total; u += F.G) {
        int p = 0; while (p < 111 && u >= pre[p + 1]) ++p;
        const int q = u - pre[p], mt = q >> 2, tn = q & 3, cnt = (int)pcnt[p], nvalid = (cnt - mt * 128 < 128) ? (cnt - mt * 128) : 128;
        const int g = p / 28; int pi = p - g * 28, elo = 0; while (pi >= 7 - elo) { pi -= 7 - elo; ++elo; } const int ehi = elo + 1 + pi;
        __syncthreads();
        if (F.tid < 128) ((LAS int*)(lds + mg::INFO_OFF))[F.tid] = PL[(size_t)p * LCAP + mt * 128 + ((F.tid < nvalid) ? F.tid : 0)];
        __syncthreads();
        const bf16_t* B0 = (const bf16_t*)(F.ws + WS_WD) + (size_t)(8 * g + elo) * 1024 * 256 + (size_t)tn * 256 * 256;
        const bf16_t* B1 = (const bf16_t*)(F.ws + WS_WD) + (size_t)(8 * g + ehi) * 1024 * 256 + (size_t)tn * 256 * 256;
        EpiMoe2 E{lds, F.out, tn, nvalid};
        mg::tile<false, EpiMoe2>(lds, (const bf16_t*)(F.ws + WS_HID), 512, B0, B1, 4, 256, 8, E);
    }
    __syncthreads();
}
__global__ void __launch_bounds__(64) s_attn(const bf16_t* __restrict__ QA, const bf16_t* __restrict__ KA, const bf16_t* __restrict__ VA, const float* __restrict__ sinks, bf16_t* __restrict__ ATT) {
    const int m = blockIdx.x, h = blockIdx.y, kvh = h >> 2, lane = threadIdx.x, s = m & (S - 1);
    __shared__ float q[64]; __shared__ float sc[160];
    q[lane] = bf2f(QA[(size_t)m * 512 + h * 64 + lane]);
    __syncthreads();
    const int j0 = (s - 127 > 0) ? (s - 127) : 0; const int nband = s - j0 + 1, nk = NMETA + nband;
    for (int i = lane; i < nk; i += 64) {
        const int kr = (i < NMETA) ? (M + i) : (m - s + j0 + (i - NMETA));
        const bf16_t* kp = KA + (size_t)kr * 128 + kvh * 64;
        float a = 0.f;
        for (int d = 0; d < 64; ++d) a += q[d] * bf2f(kp[d]);
        sc[i] = a;
    }
    __syncthreads();
    const float sk = sinks[h];
    float mx = sk;
    for (int i = 0; i < nk; ++i) mx = fmaxf(mx, sc[i]);
    float den = expf(sk - mx), o = 0.f;
    for (int i = 0; i < nk; ++i) {
        const int kr = (i < NMETA) ? (M + i) : (m - s + j0 + (i - NMETA));
        const float p = expf(sc[i] - mx); den += p; o += p * bf2f(VA[(size_t)kr * 128 + kvh * 64 + lane]);
    }
    ATT[(size_t)m * 512 + h * 64 + lane] = (bf16_t)f2bf(o / den);
}
__global__ void __launch_bounds__(128) s_gla(const bf16_t* __restrict__ QG, const bf16_t* __restrict__ KG, const bf16_t* __restrict__ VG, const float* __restrict__ GK, float* __restrict__ O) {
    const int b = blockIdx.x >> 2, h = blockIdx.x & 3, v = threadIdx.x;
    __shared__ float sq[64], sk[64], sg[64];
    float St[64];
#pragma unroll
    for (int d = 0; d < 64; ++d) St[d] = 0.f;
    for (int t = 0; t < NMETA + S; ++t) {
        const int row = (t < NMETA) ? (M + t) : (b * S + (t - NMETA));
        if (v < 64) { sq[v] = (t < NMETA) ? 0.f : bf2f(QG[(size_t)row * 256 + h * 64 + v]); sk[v] = bf2f(KG[(size_t)row * 256 + h * 64 + v]); sg[v] = expf(GK[(size_t)row * 256 + h * 64 + v]); }
        __syncthreads();
        const float vv = bf2f(VG[(size_t)row * 512 + h * 128 + v]);
        float acc = 0.f;
#pragma unroll
        for (int d = 0; d < 64; ++d) { St[d] = sg[d] * St[d] + sk[d] * vv; acc += sq[d] * St[d]; }
        if (t >= NMETA) O[(size_t)row * 512 + h * 128 + v] = acc;
        __syncthreads();
    }
}
__global__ void __launch_bounds__(128) s_gla_out(const float* __restrict__ O, const bf16_t* __restrict__ RG, const float* __restrict__ w, bf16_t* __restrict__ OG) {
    const int m = blockIdx.x, h = blockIdx.y, v = threadIdx.x;
    __shared__ float red[2];
    const float x = O[(size_t)m * 512 + h * 128 + v];
    float s = x * x;
#pragma unroll
    for (int of = 1; of < 64; of <<= 1) s += __shfl_xor(s, of);
    if ((v & 63) == 0) red[v >> 6] = s;
    __syncthreads();
    const float r = rsqrtf((red[0] + red[1]) / 128.f + EPS);
    OG[(size_t)m * 512 + h * 128 + v] = (bf16_t)f2bf(x * r * w[v] * bf2f(RG[(size_t)m * 512 + h * 128 + v]));
}
__global__ void __launch_bounds__(256) s_moe(const float* __restrict__ norm2_w, const float* __restrict__ rg, const float* __restrict__ re,
                                             const float* __restrict__ wg, const float* __restrict__ wu, const float* __restrict__ wd, float* __restrict__ out) {
    const int t = blockIdx.x, tid = threadIdx.x;
    __shared__ float xn[D]; __shared__ float red[256]; __shared__ float logits[36]; __shared__ float hid[FF]; __shared__ int sel[3]; __shared__ float selw[2];
    float* hr = out + (size_t)t * D;
    float hv4[4]; float s = 0.f;
#pragma unroll
    for (int j = 0; j < 4; ++j) { hv4[j] = hr[tid + 256 * j]; s += hv4[j] * hv4[j]; }
    red[tid] = s; __syncthreads();
    for (int o = 128; o > 0; o >>= 1) { if (tid < o) red[tid] += red[tid + o]; __syncthreads(); }
    const float r = rsqrtf(red[0] / (float)D + EPS);
#pragma unroll
    for (int j = 0; j < 4; ++j) xn[tid + 256 * j] = hv4[j] * r * norm2_w[tid + 256 * j];
    __syncthreads();
    if (tid < 36) {
        float a = 0.f;
        if (tid < 4) { for (int d = 0; d < D; ++d) a += xn[d] * rg[(size_t)d * NG + tid]; }
        else { const int g = (tid - 4) >> 3, e = (tid - 4) & 7; for (int d = 0; d < D; ++d) a += xn[d] * re[((size_t)g * D + d) * EPG + e]; }
        logits[tid] = a;
    }
    __syncthreads();
    if (tid == 0) {
        int g = 0; float mx = logits[0];
        for (int i = 1; i < NG; ++i) if (logits[i] > mx) { mx = logits[i]; g = i; }
        float den = 0.f; for (int i = 0; i < NG; ++i) den += expf(logits[i] - mx);
        const float gw = 1.f / den;
        const float* el = logits + 4 + g * 8;
        int e1 = 0; float v1 = el[0];
        for (int i = 1; i < EPG; ++i) if (el[i] > v1) { v1 = el[i]; e1 = i; }
        int e2 = -1; float v2 = -3.0e38f;
        for (int i = 0; i < EPG; ++i) if (i != e1 && el[i] > v2) { v2 = el[i]; e2 = i; }
        const float p2 = expf(v2 - v1), dn = 1.f + p2;
        sel[0] = g; sel[1] = e1; sel[2] = e2; selw[0] = gw / dn; selw[1] = gw * p2 / dn;
    }
    __syncthreads();
    float y[4] = {0.f, 0.f, 0.f, 0.f};
    const int g = sel[0];
    for (int kk = 0; kk < 2; ++kk) {
        const int e = sel[1 + kk]; const float cw = selw[kk];
        const float* pg = wg + ((size_t)(g * EPG + e) * D) * FF + tid;
        const float* pu = wu + ((size_t)(g * EPG + e) * D) * FF + tid;
        float ag = 0.f, au = 0.f;
        for (int d = 0; d < D; ++d) { const float xv = xn[d]; ag += xv * pg[(size_t)d * FF]; au += xv * pu[(size_t)d * FF]; }
        __syncthreads();
        hid[tid] = silu_f(ag) * au * cw;
        __syncthreads();
        const float* pd = wd + ((size_t)(g * EPG + e) * FF) * D;
        for (int f = 0; f < FF; ++f) { const float hv = hid[f];
#pragma unroll
            for (int j = 0; j < 4; ++j) y[j] += hv * pd[(size_t)f * D + tid + 256 * j]; }
    }
#pragma unroll
    for (int j = 0; j < 4; ++j) hr[tid + 256 * j] = hv4[j] + y[j];
}
__global__ void __launch_bounds__(256) s_moe_hid(const unsigned* __restrict__ gcnt, const int* __restrict__ EL, const float* __restrict__ EW, const bf16_t* __restrict__ XN2,
                                                 const float* __restrict__ wg, const float* __restrict__ wu, bf16_t* __restrict__ HID) {
    __shared__ float xn[D]; __shared__ int s_e, s_pos;
    const int tid = threadIdx.x;
    if (tid == 0) { int idx = blockIdx.x, e = 0; while (e < 31 && idx >= (int)gcnt[e]) { idx -= (int)gcnt[e]; ++e; } s_e = e; s_pos = idx; }
    __syncthreads();
    const int e = s_e, pos = s_pos;
    if (pos >= (int)gcnt[e]) return;
    const int ent = EL[(size_t)e * 16384 + pos], token = ent & 0xffff, slot = ent >> 16; const float cw = EW[(size_t)e * 16384 + pos];
    for (int c = tid; c < D; c += 256) xn[c] = bf2f(XN2[(size_t)token * D + c]);
    __syncthreads();
    const float* pg = wg + (size_t)e * D * FF + tid; const float* pu = wu + (size_t)e * D * FF + tid;
    float ag = 0.f, au = 0.f;
    for (int d = 0; d < D; ++d) { const float xv = xn[d]; ag += xv * pg[(size_t)d * FF]; au += xv * pu[(size_t)d * FF]; }
    HID[(size_t)token * 512 + slot * 256 + tid] = (bf16_t)f2bf(silu_f(ag) * au * cw);
}
__global__ void __launch_bounds__(256) s_moe_out(const int* __restrict__ TI, const bf16_t* __restrict__ HID, const float* __restrict__ wd, float* __restrict__ out) {
    __shared__ float hid[512];
    const int t = blockIdx.x, tid = threadIdx.x; const int ti = TI[t], ge_lo = ti & 0xff, ge_hi = (ti >> 8) & 0xff;
    hid[tid] = bf2f(HID[(size_t)t * 512 + tid]); hid[256 + tid] = bf2f(HID[(size_t)t * 512 + 256 + tid]);
    __syncthreads();
    float y[4] = {0.f, 0.f, 0.f, 0.f};
    const float* p0 = wd + (size_t)ge_lo * FF * D; const float* p1 = wd + (size_t)ge_hi * FF * D;
    for (int f = 0; f < FF; ++f) { const float a = hid[f], b = hid[256 + f];
#pragma unroll
        for (int j = 0; j < 4; ++j) y[j] += a * p0[(size_t)f * D + tid + 256 * j] + b * p1[(size_t)f * D + tid + 256 * j]; }
#pragma unroll
    for (int j = 0; j < 4; ++j) out[(size_t)t * D + tid + 256 * j] += y[j];
}
struct Args { const float* in[19]; float* out; unsigned char* ws; int ph_lo, ph_hi, li, pad; };
constexpr int N_PHASES = 10;

__global__ void __launch_bounds__(NWAVES * 64, 2) mk_fwd(Args args) {
    extern __shared__ __attribute__((aligned(16))) unsigned char lds[];
    Frame F;
    F.lds = (LAS unsigned char*)lds;
    F.MISC = (volatile LAS unsigned*)(F.lds + MISC_OFF);
    F.tid = threadIdx.x; F.lane = F.tid & 63; F.wave = __builtin_amdgcn_readfirstlane(F.tid >> 6);
    F.G = gridDim.x; { const int bx = blockIdx.x; F.vcu = (F.G % 8 == 0) ? (bx % 8) * (F.G / 8) + bx / 8 : bx; }
    unsigned char* ws = args.ws; F.ws = ws; F.out = args.out;
    F.ctl = (gu32*)(ws + WS_CTL);
    F.x = args.in[0]; F.meta = args.in[1]; F.norm1_w = args.in[2]; F.w_in = args.in[3]; F.q_norm_w = args.in[4]; F.k_norm_w = args.in[5]; F.sinks = args.in[6]; F.gate_up = args.in[7];
    F.gate_bias = args.in[8]; F.gla_norm_w = args.in[9]; F.w_ab = args.in[10]; F.w_gb = args.in[11]; F.w_out = args.in[12]; F.norm2_w = args.in[13]; F.r_g = args.in[14]; F.r_e = args.in[15];
    F.e_wg = args.in[16]; F.e_wu = args.in[17]; F.e_wd = args.in[18];
    for (int u = F.tid; u < (LDS_BYTES - LDSCTL_OFF) / 4; u += NWAVES * 64) ((LAS unsigned*)(F.lds + LDSCTL_OFF))[u] = 0u;
    __syncthreads();
    XcdBarrier bar = xcd_barrier_post((unsigned*)(F.ctl + CW_BAR) + args.li * XCD_BAR_WORDS, F.MISC + 8);
    const int lo = args.ph_lo, hi = args.ph_hi;
#define IN(k) (lo <= (k) && (k) < hi)
#define BOTH(k) (IN(k) && (k) + 1 < hi)
#define GRID_BAR() xcd_barrier(bar)

    if (IN(0)) { p0_prologue(F); p0_router_weights(F); if (BOTH(0)) GRID_BAR(); }

    if (IN(1)) {
        pg8::Gemm g{(const bf16_t*)(ws + WS_XN), (const bf16_t*)(ws + WS_WPT), MX, NP, D};
        pg8::ProjOrder So{F.G, (int)blockIdx.x};
        pg8::EpiProj E{(bf16_t*)(ws + WS_QA), (bf16_t*)(ws + WS_KA), (bf16_t*)(ws + WS_VA), (bf16_t*)(ws + WS_QG), (bf16_t*)(ws + WS_KG), (bf16_t*)(ws + WS_VG), (bf16_t*)(ws + WS_RG),
                       (bf16_t*)F.out, (bf16_t*)F.out + (size_t)M * 1024, (float*)(ws + WS_GK), F.q_norm_w, F.k_norm_w, F.gate_bias, (const float*)(ws + WS_ROPE)};
        pg8::gemm_phase<pg8::EpiProj, pg8::ProjOrder, true, true>(F.lds + RING_OFF, g, So, E);
        if (BOTH(1)) GRID_BAR();
    }

    if (IN(2)) { attn_phase(F); for (int u = blockIdx.x; u < 1028; u += F.G) gla_a_unit(F, u); if (BOTH(2)) GRID_BAR(); }
    if (IN(3)) { gla_scan_phase(F); if (BOTH(3)) GRID_BAR(); }
    if (IN(4)) { gla_c_phase(F); if (BOTH(4)) GRID_BAR(); }

    if (IN(5)) {
        pg8::Gemm g{(const bf16_t*)(ws + WS_ATT), (const bf16_t*)(ws + WS_WBT), 2 * M, 2048, 512};
        pg8::BranchOrder So{(int)blockIdx.x};
        pg8::EpiBranch E{(const bf16_t*)F.out, (const bf16_t*)F.out + (size_t)M * 1024, (bf16_t*)(ws + WS_T1), (bf16_t*)(ws + WS_MG)};
        pg8::gemm_phase<pg8::EpiBranch, pg8::BranchOrder, true, true>(F.lds + RING_OFF, g, So, E);
        if (BOTH(5)) GRID_BAR();
    }

    if (IN(6)) {
        pg8::Gemm g{(const bf16_t*)(ws + WS_MG), (const bf16_t*)(ws + WS_WOT), M, D, D};
        pg8::StaticOrder So; So.init(M, D, F.G, (int)blockIdx.x);
        pg8::EpiOut E{F.x, F.out};
        pg8::gemm_phase<pg8::EpiOut, pg8::StaticOrder, false, true>(F.lds + RING_OFF, g, So, E);
        if (BOTH(6)) GRID_BAR();
    }
    if (IN(7)) { router_phase(F); if (BOTH(7)) GRID_BAR(); }
    if (IN(8)) { moe1_phase(F); if (BOTH(8)) GRID_BAR(); }
    if (IN(9)) { moe2_phase(F); }
#undef IN
#undef BOTH
#undef GRID_BAR
}

extern "C" void kernel_launch(void* const* d_in, const int* in_sizes, int n_in, void* d_out, int out_size, void* d_ws, size_t ws_size, hipStream_t stream) {
    static int grid = 0;
    if (grid == 0) {
        if (n_in != 19 || out_size != M * D || ws_size < WS_END) { fprintf(stderr, "kernel_launch: unexpected shapes (n_in %d out %d ws %zu)\n", n_in, out_size, ws_size); grid = -1; return; }
        int dev = 0, cus = 0;
        if (hipGetDevice(&dev) != hipSuccess || hipDeviceGetAttribute(&cus, hipDeviceAttributeMultiprocessorCount, dev) != hipSuccess) { grid = -1; return; }
        if (hipFuncSetAttribute((const void*)mk_fwd, hipFuncAttributeMaxDynamicSharedMemorySize, LDS_BYTES) != hipSuccess) { fprintf(stderr, "kernel_launch: hipFuncSetAttribute failed\n"); grid = -1; return; }
        int per_cu = 0;
        if (hipOccupancyMaxActiveBlocksPerMultiprocessor(&per_cu, (const void*)mk_fwd, NWAVES * 64, LDS_BYTES) != hipSuccess || per_cu < 1) fprintf(stderr, "kernel_launch: occupancy query reports %d\n", per_cu);
        (void)hipGetLastError();
        grid = cus;
        if (grid != 256) fprintf(stderr, "kernel_launch: %d CUs (built for 256)\n", grid);
    }
    if (grid < 0) return;
    (void)hipMemsetAsync((char*)d_ws + WS_CTL, 0, CTL_ZERO_BYTES, stream);
    Args a{};
    for (int i = 0; i < 19; ++i) a.in[i] = (const float*)d_in[i];
    a.out = (float*)d_out; a.ws = (unsigned char*)d_ws;
    unsigned char* ws = (unsigned char*)d_ws;
    a.ph_lo = 0; a.ph_hi = 10; a.li = 0;
    hipLaunchKernelGGL(mk_fwd, dim3(grid), dim3(NWAVES * 64), LDS_BYTES, stream, a);
}
```

```cpp
#include <hip/hip_runtime.h>
#include <stdint.h>
#include <cstdio>

namespace cfg {
constexpr int D = 1024, NB = 8, S = 2048, NMETA = 16, BLK = 128, PADF = 112, T = S + BLK;
constexpr int M = NB * S;
constexpr int MX = M + 256;
constexpr int AH = 8, AKV = 2, HD = 64;
constexpr int GH = 4, GDK = 64, GDV = 128, GR = 16, CH = 64;
constexpr int NG = 4, EPG = 8, FF = 256, NE = NG * EPG;
constexpr int INTOT = 4368;
constexpr int OFF_QA = 0, OFF_KA = 512, OFF_VA = 640, OFF_QG = 768, OFF_KG = 1024, OFF_VG = 1280, OFF_RG = 1792, OFF_GD = 2304, OFF_GA = 2320, OFF_GG = 3344;
constexpr float EPS = 1e-6f;
constexpr int NP = 4608;
constexpr int NPOS = S + NMETA;
}
using namespace cfg;

typedef unsigned short bf16_t;
#define GAS __attribute__((address_space(1)))
#define LAS __attribute__((address_space(3)))
typedef unsigned v4u __attribute__((ext_vector_type(4)));
typedef unsigned v2u __attribute__((ext_vector_type(2)));
typedef float f32x4 __attribute__((ext_vector_type(4)));
typedef float f32x16 __attribute__((ext_vector_type(16)));
typedef short bf16x8 __attribute__((ext_vector_type(8)));
typedef short bf16x4 __attribute__((ext_vector_type(4)));
typedef GAS unsigned gu32;
#define RLX_AGENT __ATOMIC_RELAXED, __HIP_MEMORY_SCOPE_AGENT
#define LDS_WAIT() asm volatile("s_waitcnt lgkmcnt(0)" ::: "memory")
#define VM_WAIT() asm volatile("s_waitcnt vmcnt(0)" ::: "memory")

constexpr size_t MiB = 1u << 20;
constexpr size_t WS_CTL  = 0;
constexpr size_t CTL_ZERO_BYTES = 1 * MiB;
constexpr size_t WS_ROPE = 1 * MiB;
constexpr size_t WS_WBT  = 2 * MiB;
constexpr size_t WS_WOT  = 4 * MiB;
constexpr size_t WS_WGU  = 6 * MiB;
constexpr size_t WS_WD   = 38 * MiB;
constexpr size_t WS_R1   = 54 * MiB;
constexpr size_t WS_R2   = WS_R1 + (size_t)MX * 1024 * 2;
constexpr size_t WS_QA   = WS_R2 + (size_t)NP * 1024 * 2;
constexpr size_t WS_VG   = WS_QA + (size_t)M * 512 * 2;
constexpr size_t WS_KA   = WS_VG + (size_t)MX * 512 * 2;
constexpr size_t WS_VA   = WS_KA + (size_t)MX * 128 * 2;
constexpr size_t WS_QG   = WS_VA + (size_t)MX * 128 * 2;
constexpr size_t WS_KG   = WS_QG + (size_t)M * 256 * 2;
constexpr size_t WS_RG   = WS_KG + (size_t)MX * 256 * 2;
constexpr size_t WS_GK   = WS_RG + (size_t)M * 512 * 2;
constexpr size_t WS_ATT  = WS_GK + (size_t)MX * 256 * 4;
constexpr size_t WS_OG   = WS_ATT + (size_t)M * 512 * 2;
constexpr size_t WS_KV   = WS_OG;
constexpr size_t WS_ST   = WS_KV + (size_t)1028 * 8192 * 4;
constexpr size_t WS_DEC  = WS_ST + (size_t)1024 * 8192 * 2;
constexpr size_t WS_END  = WS_DEC + (size_t)1028 * 64 * 4;
constexpr size_t WS_MG   = WS_QA;
constexpr size_t WS_T1   = WS_R1;
constexpr size_t WS_OI   = WS_R1;
constexpr size_t WS_XN   = WS_R1;
constexpr size_t WS_WPT  = WS_R2;
constexpr size_t WS_QH   = WS_R2;
static_assert(WS_END <= 256 * MiB, "d_ws map");
static_assert(WS_QA + (size_t)M * 1024 * 2 <= WS_KA, "MERGED overlays QA|VG only");

__device__ __forceinline__ float bf2f(bf16_t v) { return __builtin_bit_cast(float, (unsigned)v << 16); }
__device__ __forceinline__ unsigned f2bf(float f) { unsigned u = __builtin_bit_cast(unsigned, f); return (u + 0x7fffu + ((u >> 16) & 1u)) >> 16; }
__device__ __forceinline__ unsigned pk2(float lo, float hi) { return f2bf(lo) | (f2bf(hi) << 16); }
__device__ __forceinline__ float fast_sigmoid(float z) { return __builtin_amdgcn_rcpf(1.f + __expf(-z)); }
__device__ __forceinline__ float log_sigmoid_f(float z) { return fminf(z, 0.f) - log1pf(expf(-fabsf(z))); }
__device__ __forceinline__ float sigmoid_f(float z) { return 1.f / (1.f + expf(-z)); }
__device__ __forceinline__ float silu_f(float z) { return z / (1.f + expf(-z)); }
namespace pg8 {
#define PG8_LAS __attribute__((address_space(3)))
typedef unsigned short bf16_t;
typedef short bf16x8 __attribute__((ext_vector_type(8)));
typedef float f32x4 __attribute__((ext_vector_type(4)));
typedef unsigned u32x4 __attribute__((ext_vector_type(4)));
constexpr int BM = 256, BK = 64, HALF = 128, HTB = HALF * BK * 2  , STAGE_BYTES = 8 * HTB, NXCD = 8, WGM = 8;

__host__ __device__ __forceinline__ int lds_byte(int r, int c) { const int st = (r >> 4) * 2 + (c >> 5), rr = r & 15, cc = c & 31, ob = rr * 64 + cc * 2; return st * 1024 + (ob ^ (((ob >> 9) & 1) << 5)); }
__host__ __device__ __forceinline__ void stage_rc(int b, int& R, int& C) { const int st = b / 1024, sb = b % 1024, swz = sb ^ (((sb >> 9) & 1) << 5); R = (st >> 1) * 16 + swz / 64; C = (st & 1) * 32 + (swz % 64) / 2; }
__host__ __device__ __forceinline__ int perm32(int rho) { const int n = rho >> 4, i = rho & 15; return 8 * (i >> 2) + 4 * n + (i & 3); }

struct Unit { int pm, pn; };
struct Gemm { const bf16_t* A; const bf16_t* Bt; int M, N, K; };

struct StaticOrder {
    int nM, nN, nwg, G, c;
    __host__ __device__ void init(int M, int N, int G_, int c_) { nM = M / BM; nN = N / BM; nwg = nM * nN; G = G_; c = c_; }
    __host__ __device__ bool next(int i, Unit& u) const {
        const long L = (long)i * G + c; if (L >= nwg) return false;
        int wgid = (int)L; { const int q = nwg / NXCD, r = nwg % NXCD, xcd = wgid % NXCD, off = wgid / NXCD; wgid = (xcd < r ? xcd * (q + 1) : r * (q + 1) + (xcd - r) * q) + off; }
        const int nig = WGM * nN, gid = wgid / nig, fm = gid * WGM, gsz = (nM - fm) < WGM ? (nM - fm) : WGM;
        u.pm = fm + ((wgid % nig) % gsz); u.pn = (wgid % nig) / gsz; return true;
    }
    __device__ __forceinline__ void a_ready(const Unit&) const {}
    __device__ __forceinline__ void done(const Unit&) const {}
};

__device__ __forceinline__ unsigned cvt_pk_bf16(float lo, float hi) { unsigned r; asm volatile("v_cvt_pk_bf16_f32 %0, %1, %2" : "=v"(r) : "v"(lo), "v"(hi)); return r; }
struct ProjOrder {
    int G, c;
    __device__ bool next(int i, Unit& u) const {
        const int L = i * G + c; constexpr int nwg = 64 * 18;
        if (L >= nwg + 5) return false;
        if (L >= nwg) { const int k = L - nwg; u.pm = 64; u.pn = (k == 0) ? 2 : (k == 1) ? 4 : (k == 2) ? 5 : (k == 3) ? 6 : 9; return true; }
        const int q = nwg / NXCD, xcd = L % NXCD, off = L / NXCD; const int wgid = xcd * q + off;
        const int nig = WGM * 18, gid = wgid / nig, fm = gid * WGM;
        u.pm = fm + ((wgid % nig) % WGM); u.pn = (wgid % nig) / WGM; return true;
    }
    __device__ __forceinline__ void a_ready(const Unit&) const {}
    __device__ __forceinline__ void done(const Unit&) const {}
};
struct BranchOrder {
    int c;
    __device__ bool next(int i, Unit& u) const {
        if (i >= 2) return false;
        constexpr int nwg = 256; const int q = nwg / NXCD, xcd = c % NXCD, off = c / NXCD; const int wgid = xcd * q + off;
        const int nig = WGM * 4, gid = wgid / nig, fm = gid * WGM;
        u.pm = fm + ((wgid % nig) % WGM) + 64 * i; u.pn = (wgid % nig) / WGM + 4 * i; return true;
    }
    __device__ __forceinline__ void a_ready(const Unit&) const {}
    __device__ __forceinline__ void done(const Unit&) const {}
};

__device__ __forceinline__ v4u pack8(const f32x4& a, const f32x4& b) { v4u w; w.x = cvt_pk_bf16(a[0], a[1]); w.y = cvt_pk_bf16(a[2], a[3]); w.z = cvt_pk_bf16(b[0], b[1]); w.w = cvt_pk_bf16(b[2], b[3]); return w; }
__device__ __forceinline__ void unpack8(const v4u& w, f32x4& a, f32x4& b) {
    a[0] = __builtin_bit_cast(float, w.x << 16); a[1] = __builtin_bit_cast(float, w.x & 0xffff0000u); a[2] = __builtin_bit_cast(float, w.y << 16); a[3] = __builtin_bit_cast(float, w.y & 0xffff0000u);
    b[0] = __builtin_bit_cast(float, w.z << 16); b[1] = __builtin_bit_cast(float, w.z & 0xffff0000u); b[2] = __builtin_bit_cast(float, w.w << 16); b[3] = __builtin_bit_cast(float, w.w & 0xffff0000u);
}

struct EpiProj {
    static constexpr bool PERM = true, AFTER_DRAIN = false;
    bf16_t *QA, *KA, *VA, *QG, *KG, *VG, *RG, *SA, *SG; float* GK;
    const float *qnw, *knw, *gbias; const float* rope;
    __device__ __forceinline__ void operator()(const f32x4 (&acc)[2][2][4][2], const Unit& u, int wr, int wc, int fr, int fq) const {
        const int pn = u.pn; const int row0 = u.pm * BM + wr * 64 + fr;
        if (pn < 2 || (pn == 2 && wc < 2)) {
            const bool isq = pn < 2; const int head = isq ? pn * 4 + wc : wc; const float* nw = isq ? qnw : knw; bf16_t* dst = isq ? QA : KA; const int ldd = isq ? 512 : 128;
            const float osc = isq ? 0.125f : 1.0f;
            const f32x4 w1a = *(const f32x4*)(nw + 8 * fq), w1b = *(const f32x4*)(nw + 8 * fq + 4), w2a = *(const f32x4*)(nw + 32 + 8 * fq), w2b = *(const f32x4*)(nw + 32 + 8 * fq + 4);
            f32x4 csb[3][4];
#define EP_POS(g) ((row0 + ((g) >> 2) * HALF + ((g) & 3) * 16) < M ? ((row0 + ((g) >> 2) * HALF + ((g) & 3) * 16) & (S - 1)) + NMETA : (row0 + ((g) >> 2) * HALF + ((g) & 3) * 16) - M)
#define EP_LOAD(g) do { const float* rp_ = rope + ((size_t)EP_POS(g) * 32 + 8 * fq) * 2; _Pragma("unroll") for (int q_ = 0; q_ < 4; ++q_) csb[(g) % 3][q_] = *(const f32x4*)(rp_ + 4 * q_); } while (0)
            EP_LOAD(0); EP_LOAD(1);
#pragma unroll
            for (int g = 0; g < 8; ++g) {
                    if (g + 2 < 8) EP_LOAD(g + 2);
                    const int ai = g >> 2, m = g & 3;
                    const int row = row0 + ai * HALF + m * 16;
                    f32x4 x1a = acc[ai][0][m][0], x1b = acc[ai][0][m][1], x2a = acc[ai][1][m][0], x2b = acc[ai][1][m][1];
                    float ss = 0.f;
#pragma unroll
                    for (int j = 0; j < 4; ++j) ss += x1a[j] * x1a[j] + x1b[j] * x1b[j] + x2a[j] * x2a[j] + x2b[j] * x2b[j];
                    ss += __shfl_xor(ss, 16); ss += __shfl_xor(ss, 32);
                    const float r = rsqrtf(ss * (1.0f / 64.0f) + EPS) * osc;
                    const f32x4 cs0 = csb[g % 3][0], cs1 = csb[g % 3][1], cs2 = csb[g % 3][2], cs3 = csb[g % 3][3];
                    x1a = x1a * w1a * r; x1b = x1b * w1b * r; x2a = x2a * w2a * r; x2b = x2b * w2b * r;
                    f32x4 o1a, o1b, o2a, o2b;
                    o1a[0] = x1a[0] * cs0[0] - x2a[0] * cs0[1]; o2a[0] = x2a[0] * cs0[0] + x1a[0] * cs0[1];
                    o1a[1] = x1a[1] * cs0[2] - x2a[1] * cs0[3]; o2a[1] = x2a[1] * cs0[2] + x1a[1] * cs0[3];
                    o1a[2] = x1a[2] * cs1[0] - x2a[2] * cs1[1]; o2a[2] = x2a[2] * cs1[0] + x1a[2] * cs1[1];
                    o1a[3] = x1a[3] * cs1[2] - x2a[3] * cs1[3]; o2a[3] = x2a[3] * cs1[2] + x1a[3] * cs1[3];
                    o1b[0] = x1b[0] * cs2[0] - x2b[0] * cs2[1]; o2b[0] = x2b[0] * cs2[0] + x1b[0] * cs2[1];
                    o1b[1] = x1b[1] * cs2[2] - x2b[1] * cs2[3]; o2b[1] = x2b[1] * cs2[2] + x1b[1] * cs2[3];
                    o1b[2] = x1b[2] * cs3[0] - x2b[2] * cs3[1]; o2b[2] = x2b[2] * cs3[0] + x1b[2] * cs3[1];
                    o1b[3] = x1b[3] * cs3[2] - x2b[3] * cs3[3]; o2b[3] = x2b[3] * cs3[2] + x1b[3] * cs3[3];
                    bf16_t* rowp = dst + (size_t)row * ldd + head * 64 + 8 * fq;
                    *(v4u*)(rowp) = pack8(o1a, o1b); *(v4u*)(rowp + 32) = pack8(o2a, o2b);
                }
#undef EP_LOAD
#undef EP_POS
            return;
        }
        if (pn == 2) {
#pragma unroll
            for (int ai = 0; ai < 2; ++ai)
#pragma unroll
                for (int m = 0; m < 4; ++m) { const int row = row0 + ai * HALF + m * 16; bf16_t* rowp = VA + (size_t)row * 128 + (wc - 2) * 64 + 8 * fq;
#pragma unroll
                    for (int bj = 0; bj < 2; ++bj) *(v4u*)(rowp + 32 * bj) = pack8(acc[ai][bj][m][0], acc[ai][bj][m][1]); }
            return;
        }
        const int ct = wc * 32 + 8 * fq;
        if (pn == 9) {
#pragma unroll
            for (int bj = 0; bj < 2; ++bj) { const int col = ct + bj * HALF; const f32x4 b0 = *(const f32x4*)(gbias + col), b1 = *(const f32x4*)(gbias + col + 4);
#pragma unroll
                for (int ai = 0; ai < 2; ++ai)
#pragma unroll
                    for (int m = 0; m < 4; ++m) { const int row = row0 + ai * HALF + m * 16; f32x4 z0 = acc[ai][bj][m][0] + b0, z1 = acc[ai][bj][m][1] + b1;
#pragma unroll
                        for (int j = 0; j < 4; ++j) { z0[j] = (fminf(z0[j], 0.f) - __logf(1.f + __expf(-fabsf(z0[j])))) * 0.0625f; z1[j] = (fminf(z1[j], 0.f) - __logf(1.f + __expf(-fabsf(z1[j])))) * 0.0625f; }
                        float* rowp = GK + (size_t)row * 256 + col; *(f32x4*)rowp = z0; *(f32x4*)(rowp + 4) = z1; } }
            return;
        }
        bf16_t* dst; int ldd, cbase, act; float sc = 1.f;
        if (pn == 3) { dst = QG; ldd = 256; cbase = 0; act = 0; sc = 0.125f; }
        else if (pn == 4) { dst = KG; ldd = 256; cbase = 0; act = 0; }
        else if (pn < 7) { dst = VG; ldd = 512; cbase = (pn - 5) * 256; act = 0; }
        else if (pn < 9) { dst = RG; ldd = 512; cbase = (pn - 7) * 256; act = 1; }
        else if (pn < 14) { dst = SA; ldd = 1024; cbase = (pn - 10) * 256; act = 2; }
        else { dst = SG; ldd = 1024; cbase = (pn - 14) * 256; act = 2; }
#pragma unroll
        for (int ai = 0; ai < 2; ++ai)
#pragma unroll
            for (int m = 0; m < 4; ++m) { const int row = row0 + ai * HALF + m * 16; bf16_t* rowp = dst + (size_t)row * ldd + cbase + ct;
#pragma unroll
                for (int bj = 0; bj < 2; ++bj) { f32x4 v0 = acc[ai][bj][m][0] * sc, v1 = acc[ai][bj][m][1] * sc;
                    if (act != 0) {
#pragma unroll
                        for (int j = 0; j < 4; ++j) { const float s0 = fast_sigmoid(v0[j]), s1 = fast_sigmoid(v1[j]); v0[j] = (act == 1) ? v0[j] * s0 : s0; v1[j] = (act == 1) ? v1[j] * s1 : s1; } }
                    *(v4u*)(rowp + bj * HALF) = pack8(v0, v1); } }
    }
};

struct EpiBranch {
    static constexpr bool PERM = true, AFTER_DRAIN = false;
    const bf16_t *SA, *SG; bf16_t *T1, *MG;
    __device__ __forceinline__ void operator()(const f32x4 (&acc)[2][2][4][2], const Unit& u, int wr, int wc, int fr, int fq) const {
        const bool second = u.pm >= 64; const int pm = u.pm & 63, pn = u.pn & 3;
        const int row0 = pm * BM + wr * 64 + fr, col0 = pn * BM + wc * 32 + 8 * fq;
        const bf16_t* G = second ? SG : SA;
        v4u gv[3][2], tv[3][2];
#define EB_LOAD(g) do { const size_t off_ = (size_t)(row0 + ((g) >> 2) * HALF + ((g) & 3) * 16) * 1024 + col0; _Pragma("unroll") for (int bj_ = 0; bj_ < 2; ++bj_) { \
            gv[(g) % 3][bj_] = *(const v4u*)(G + off_ + bj_ * HALF); if (second) tv[(g) % 3][bj_] = *(const v4u*)(T1 + off_ + bj_ * HALF); } } while (0)
        EB_LOAD(0); EB_LOAD(1);
#pragma unroll
        for (int g = 0; g < 8; ++g) {
            if (g + 2 < 8) EB_LOAD(g + 2);
            const int ai = g >> 2, m = g & 3; const size_t off = (size_t)(row0 + ai * HALF + m * 16) * 1024 + col0;
#pragma unroll
            for (int bj = 0; bj < 2; ++bj) { f32x4 g0, g1; unpack8(gv[g % 3][bj], g0, g1);
                f32x4 v0 = acc[ai][bj][m][0] * g0, v1 = acc[ai][bj][m][1] * g1;
                if (second) { f32x4 t0, t1; unpack8(tv[g % 3][bj], t0, t1); v0 = v0 + t0; v1 = v1 + t1; *(v4u*)(MG + off + bj * HALF) = pack8(v0, v1); }
                else *(v4u*)(T1 + off + bj * HALF) = pack8(v0, v1); }
        }
#undef EB_LOAD
    }
};

struct EpiOut {
    static constexpr bool PERM = false, AFTER_DRAIN = false;
    const float* X; float* O;
    __device__ __forceinline__ void operator()(const f32x4 (&acc)[2][2][4][2], const Unit& u, int wr, int wc, int fr, int fq) const {
        const int row0 = u.pm * BM + wr * 64 + fr, col0 = u.pn * BM + wc * 32 + 4 * fq;
        f32x4 xb[3][4];
#define EO_LOAD(g) do { const size_t off_ = (size_t)(row0 + ((g) >> 2) * HALF + ((g) & 3) * 16) * 1024 + col0; _Pragma("unroll") for (int q_ = 0; q_ < 4; ++q_) xb[(g) % 3][q_] = *(const f32x4*)(X + off_ + (q_ >> 1) * HALF + (q_ & 1) * 16); } while (0)
        EO_LOAD(0); EO_LOAD(1);
#pragma unroll
        for (int g = 0; g < 8; ++g) {
            if (g + 2 < 8) EO_LOAD(g + 2);
            const int ai = g >> 2, m = g & 3; const size_t off = (size_t)(row0 + ai * HALF + m * 16) * 1024 + col0;
#pragma unroll
            for (int q = 0; q < 4; ++q) *(f32x4*)(O + off + (q >> 1) * HALF + (q & 1) * 16) = xb[g % 3][q] + acc[ai][q >> 1][m][q & 1];
        }
#undef EO_LOAD
    }
};
template <class Epi, class Sched, bool ALIGN_EPI = false, bool SP2 = false>
__device__ __forceinline__ void gemm_phase(PG8_LAS unsigned char* lds, const Gemm g, const Sched& S, const Epi& E) {
    const int tid = threadIdx.x, wid = __builtin_amdgcn_readfirstlane(tid >> 6), lane = tid & 63, wr = wid >> 2, wc = wid & 3, fr = lane & 15, fq = lane >> 4;
    const int K = g.K, nt = K / BK;
    unsigned voffA[2], voffB[2];
#pragma unroll
    for (int i = 0; i < 2; ++i) { int R, C; stage_rc(tid * 16 + i * 8192, R, C); const int Rb = Epi::PERM ? ((R & ~31) + perm32(R & 31)) : R;
        voffA[i] = (unsigned)(R * K + C) * 2u; voffB[i] = (unsigned)(Rb * K + C) * 2u; }
    const size_t kstep = (size_t)(BK * 2);
    const size_t hstep = (size_t)HALF * K * 2;
    const size_t tstep = 2 * hstep;
    const unsigned ldsw = (unsigned)wid * 1024u;
    const int aoff = lds_byte(wr * 64 + fr, fq * 8), boff = lds_byte(wc * 32 + fr, fq * 8);
#define PG8_SA(b, h) (((b) * 2 + (h)) * HTB)
#define PG8_SB(b, h) ((4 + (b) * 2 + (h)) * HTB)
#define PG8_STAGE(bufoff, gbase, voff) do { _Pragma("unroll") for (int _i = 0; _i < 2; ++_i) \
        __builtin_amdgcn_global_load_lds((const unsigned*)((const char*)(gbase) + (voff)[_i]), (PG8_LAS unsigned*)(lds + (bufoff) + ldsw + _i * 8192), 16, 0, 0); } while (0)
#define PG8_LDA(dst, b, h) do { _Pragma("unroll") for (int m = 0; m < 4; ++m) _Pragma("unroll") for (int k = 0; k < 2; ++k) dst[m][k] = *(const PG8_LAS bf16x8*)(lds + PG8_SA(b, h) + aoff + m * 2048 + k * 1024); } while (0)
#define PG8_LDB(dst, b, h) do { _Pragma("unroll") for (int n = 0; n < 2; ++n) _Pragma("unroll") for (int k = 0; k < 2; ++k) dst[n][k] = *(const PG8_LAS bf16x8*)(lds + PG8_SB(b, h) + boff + n * 2048 + k * 1024); } while (0)
#define PG8_MMA(ai, bj, At, Bt) do { __builtin_amdgcn_s_setprio(1); _Pragma("unroll") for (int m = 0; m < 4; ++m) _Pragma("unroll") for (int n = 0; n < 2; ++n) _Pragma("unroll") for (int k = 0; k < 2; ++k) \
        acc[ai][bj][m][n] = __builtin_amdgcn_mfma_f32_16x16x32_bf16(Bt[n][k], At[m][k], acc[ai][bj][m][n], 0, 0, 0); __builtin_amdgcn_s_setprio(0); } while (0)
#define PG8_WAIT_V(n) asm volatile("s_waitcnt vmcnt(" #n ")" ::: "memory")
#define PG8_WAIT_L(n) asm volatile("s_waitcnt lgkmcnt(" #n ")" ::: "memory")
#define PG8_BAR __builtin_amdgcn_s_barrier()
#define PG8_SCHED __builtin_amdgcn_sched_barrier(0)
    Unit cur, nxt; int ui = 0;
    if (!S.next(0, cur)) return;
    f32x4 acc[2][2][4][2];
#pragma unroll
    for (int a = 0; a < 2; ++a)
#pragma unroll
        for (int b = 0; b < 2; ++b)
#pragma unroll
            for (int m = 0; m < 4; ++m)
#pragma unroll
                for (int n = 0; n < 2; ++n) acc[a][b][m][n] = (f32x4){0.f, 0.f, 0.f, 0.f};
    bf16x8 At[4][2], B0[2][2], B1[2][2];
    const char* cA = (const char*)g.A + (size_t)cur.pm * tstep; const char* cB = (const char*)g.Bt + (size_t)cur.pn * tstep;
    S.a_ready(cur);
    if constexpr (SP2) {
        PG8_STAGE(PG8_SB(0, 0), cB, voffB); PG8_STAGE(PG8_SB(0, 1), cB + hstep, voffB); PG8_STAGE(PG8_SA(0, 0), cA, voffA); PG8_STAGE(PG8_SA(0, 1), cA + hstep, voffA);
        if (wr == 1) PG8_BAR;
        PG8_WAIT_V(2); PG8_BAR;
        PG8_STAGE(PG8_SB(1, 0), cB + kstep, voffB); PG8_STAGE(PG8_SA(1, 0), cA + kstep, voffA); PG8_STAGE(PG8_SB(1, 1), cB + hstep + kstep, voffB);
        PG8_WAIT_V(6); PG8_BAR;
    } else {
        PG8_STAGE(PG8_SB(0, 0), cB, voffB); PG8_STAGE(PG8_SA(0, 0), cA, voffA); PG8_STAGE(PG8_SB(0, 1), cB + hstep, voffB); PG8_STAGE(PG8_SA(0, 1), cA + hstep, voffA);
        if (wr == 1) PG8_BAR;
        PG8_WAIT_V(4); PG8_BAR;
        PG8_STAGE(PG8_SB(1, 0), cB + kstep, voffB); PG8_STAGE(PG8_SA(1, 0), cA + kstep, voffA); PG8_STAGE(PG8_SB(1, 1), cB + hstep + kstep, voffB);
        PG8_WAIT_V(6); PG8_BAR;
    }
    for (;;) {
        const bool has_next = S.next(ui + 1, nxt);
        const char* nA = has_next ? (const char*)g.A + (size_t)nxt.pm * tstep : cA; const char* nB = has_next ? (const char*)g.Bt + (size_t)nxt.pn * tstep : cB;
        for (int t = 0; t < nt; t += 2) {
            const bool last = (t == nt - 2);
            const char* a1 = cA + (size_t)(t + 1) * kstep;
            const char* a2 = last ? nA : cA + (size_t)(t + 2) * kstep; const char* b2 = last ? nB : cB + (size_t)(t + 2) * kstep;
            const char* a3 = a2 + kstep; const char* b3 = b2 + kstep;
            if (last && has_next) S.a_ready(nxt);
            if constexpr (SP2) {
            PG8_LDB(B0, 0, 0); PG8_LDB(B1, 0, 1); PG8_SCHED; PG8_LDA(At, 0, 0); PG8_STAGE(PG8_SA(1, 1), a1 + hstep, voffA);
            PG8_WAIT_V(8); PG8_WAIT_L(0); PG8_BAR; PG8_MMA(0, 0, At, B0); PG8_MMA(0, 1, At, B1); PG8_BAR; PG8_SCHED;
            PG8_LDA(At, 0, 1); PG8_STAGE(PG8_SB(0, 0), b2, voffB); PG8_STAGE(PG8_SB(0, 1), b2 + hstep, voffB); PG8_STAGE(PG8_SA(0, 0), a2, voffA);
            PG8_WAIT_V(8); PG8_WAIT_L(0); PG8_BAR; PG8_MMA(1, 0, At, B0); PG8_MMA(1, 1, At, B1); PG8_BAR; PG8_SCHED;
            PG8_LDB(B0, 1, 0); PG8_LDB(B1, 1, 1); PG8_SCHED; PG8_LDA(At, 1, 0); PG8_STAGE(PG8_SA(0, 1), a2 + hstep, voffA);
            PG8_WAIT_V(8); PG8_WAIT_L(0); PG8_BAR; PG8_MMA(0, 0, At, B0); PG8_MMA(0, 1, At, B1); PG8_BAR; PG8_SCHED;
            PG8_LDA(At, 1, 1); PG8_STAGE(PG8_SB(1, 0), b3, voffB); PG8_STAGE(PG8_SB(1, 1), b3 + hstep, voffB); PG8_STAGE(PG8_SA(1, 0), a3, voffA);
            PG8_WAIT_V(8); PG8_WAIT_L(0); PG8_BAR; PG8_MMA(1, 0, At, B0); PG8_MMA(1, 1, At, B1); PG8_BAR; PG8_SCHED;
            } else {
            PG8_LDB(B0, 0, 0); PG8_SCHED; PG8_LDA(At, 0, 0); PG8_STAGE(PG8_SA(1, 1), a1 + hstep, voffA);
            PG8_WAIT_L(8); PG8_BAR; PG8_WAIT_L(0); PG8_MMA(0, 0, At, B0); PG8_BAR; PG8_SCHED;
            PG8_LDB(B1, 0, 1); PG8_STAGE(PG8_SB(0, 0), b2, voffB);
            PG8_BAR; PG8_WAIT_L(0); PG8_MMA(0, 1, At, B1); PG8_BAR;
            PG8_LDA(At, 0, 1); PG8_STAGE(PG8_SA(0, 0), a2, voffA);
            PG8_BAR; PG8_WAIT_L(0); PG8_MMA(1, 0, At, B0); PG8_BAR; PG8_SCHED;
            PG8_STAGE(PG8_SB(0, 1), b2 + hstep, voffB);
            PG8_WAIT_V(6); PG8_BAR; PG8_MMA(1, 1, At, B1); PG8_BAR;
            PG8_LDB(B0, 1, 0); PG8_SCHED; PG8_LDA(At, 1, 0); PG8_STAGE(PG8_SA(0, 1), a2 + hstep, voffA);
            PG8_WAIT_L(8); PG8_BAR; PG8_WAIT_L(0); PG8_MMA(0, 0, At, B0); PG8_BAR; PG8_SCHED;
            PG8_LDB(B1, 1, 1); PG8_STAGE(PG8_SB(1, 0), b3, voffB);
            PG8_BAR; PG8_WAIT_L(0); PG8_MMA(0, 1, At, B1); PG8_BAR;
            PG8_LDA(At, 1, 1); PG8_STAGE(PG8_SA(1, 0), a3, voffA);
            PG8_BAR; PG8_WAIT_L(0); PG8_MMA(1, 0, At, B0); PG8_BAR; PG8_SCHED;
            PG8_STAGE(PG8_SB(1, 1), b3 + hstep, voffB);
            PG8_WAIT_V(6); PG8_BAR; PG8_MMA(1, 1, At, B1); PG8_BAR;
            }
        }
        if constexpr (ALIGN_EPI) { if (wr == 0) PG8_BAR; }
        if constexpr (!Epi::AFTER_DRAIN) { E(acc, cur, wr, wc, fr, fq); S.done(cur); }
        if (!has_next) break;
#pragma unroll
        for (int a = 0; a < 2; ++a)
#pragma unroll
            for (int b = 0; b < 2; ++b)
#pragma unroll
                for (int m = 0; m < 4; ++m)
#pragma unroll
                    for (int n = 0; n < 2; ++n) acc[a][b][m][n] = (f32x4){0.f, 0.f, 0.f, 0.f};
        cur = nxt; cA = nA; cB = nB; ++ui;
        if constexpr (ALIGN_EPI) { if (wr == 1) PG8_BAR; }
    }
    PG8_WAIT_V(0);
    if constexpr (!ALIGN_EPI) { if (wr == 0) PG8_BAR; }
    PG8_BAR;
    if constexpr (Epi::AFTER_DRAIN) { E.fused(acc, cur, wr, wc, fr, fq, lds, wid, lane); S.done(cur); }
#undef PG8_SA
#undef PG8_SB
#undef PG8_STAGE
#undef PG8_LDA
#undef PG8_LDB
#undef PG8_MMA
#undef PG8_WAIT_V
#undef PG8_WAIT_L
#undef PG8_BAR
#undef PG8_SCHED
}
}
#define XB_TMO      128
#define XB_XCNT(j)  (256  + 64 * (j))
#define XB_XSUB(j)  (1280 + 64 * (j))
#define XB_XGEN(j)  (2304 + 64 * (j))
#define XB_TOP      3328
#define XB_TOPGEN   3392
#define XCD_BAR_WORDS 3456
#define XB_SPIN_CAP (1u << 18)

__device__ __forceinline__ unsigned xb_ld(unsigned* p)              { return __hip_atomic_load(p, __ATOMIC_RELAXED, __HIP_MEMORY_SCOPE_AGENT); }
__device__ __forceinline__ unsigned xb_add(unsigned* p, unsigned v) { return __hip_atomic_fetch_add(p, v, __ATOMIC_RELAXED, __HIP_MEMORY_SCOPE_AGENT); }
__device__ __forceinline__ unsigned xb_xcc_id() { return (unsigned)__builtin_amdgcn_s_getreg((3 << 11) | 20) & 0xFu; }
#define XB_SPIN(cond, bar) do { unsigned _sp = 0; while (cond) { __builtin_amdgcn_s_sleep(1); \
    if ((++_sp & 255u) == 0u) { if (xb_ld(&(bar)[XB_TMO])) break; if (_sp > XB_SPIN_CAP) { atomicAdd(&(bar)[XB_TMO], 1u); break; } } } } while (0)

struct XcdBarrier {
    unsigned* bar; unsigned x;
    volatile LAS unsigned* st;
};

__device__ __forceinline__ XcdBarrier xcd_barrier_post(unsigned* bar, volatile LAS unsigned* st) {
    XcdBarrier b; b.bar = bar; b.x = xb_xcc_id(); b.st = st;
    if (threadIdx.x == 0) (void)xb_add(&bar[XB_XCNT(b.x)], 1u);
    return b;
}
__device__ __forceinline__ void xcd_barrier_complete(unsigned* bar, unsigned x, unsigned& nloc, unsigned& nx) {
    const unsigned G = gridDim.x * gridDim.y * gridDim.z;
    unsigned sum, cnt, mine, sp = 0u;
    for (;;) {
        sum = 0u; cnt = 0u; mine = 0u;
#pragma unroll
        for (unsigned j = 0; j < 16; ++j) { const unsigned c = xb_ld(&bar[XB_XCNT(j)]); sum += c; cnt += (c > 0u) ? 1u : 0u; mine = (j == x) ? c : mine; }
        if (sum == G) break;
        __builtin_amdgcn_s_sleep(1);
        if ((++sp & 255u) == 0u) { if (xb_ld(&bar[XB_TMO])) break; if (sp > XB_SPIN_CAP) { atomicAdd(&bar[XB_TMO], 1u); break; } }
    }
    nloc = mine > 0u ? mine : 1u; nx = cnt > 0u ? cnt : 1u;
}

__device__ __forceinline__ void xcd_barrier(const XcdBarrier& b) {
    asm volatile("s_waitcnt vmcnt(0)" ::: "memory");
    __syncthreads();
    if (threadIdx.x == 0) {
        unsigned* bar = b.bar;
        __builtin_amdgcn_s_waitcnt(0);
        unsigned nloc = b.st[0], nx = b.st[1];
        if (nloc == 0u) { xcd_barrier_complete(bar, b.x, nloc, nx); b.st[0] = nloc; b.st[1] = nx; }
        const unsigned old = xb_add(&bar[XB_XSUB(b.x)], 1u);
        const unsigned gen = old / nloc;
        if (old + 1u == (gen + 1u) * nloc) {
            __builtin_amdgcn_fence(__ATOMIC_RELEASE, "agent");
            asm volatile("s_waitcnt vmcnt(0)" ::: "memory");
            const unsigned og = xb_add(&bar[XB_TOP], 1u);
            const unsigned tg = og / nx;
            if (og + 1u == (tg + 1u) * nx) xb_add(&bar[XB_TOPGEN], 1u);
            else XB_SPIN(xb_ld(&bar[XB_TOPGEN]) == tg, bar);
            __builtin_amdgcn_fence(__ATOMIC_ACQUIRE, "agent");
            xb_add(&bar[XB_XGEN(b.x)], 1u);
            asm volatile("s_waitcnt vmcnt(0)" ::: "memory");
        } else {
            XB_SPIN(xb_ld(&bar[XB_XGEN(b.x)]) == gen, bar);
            __builtin_amdgcn_fence(__ATOMIC_ACQUIRE, "agent");
            asm volatile("s_waitcnt vmcnt(0)" ::: "memory");
        }
    }
    __syncthreads();
}
constexpr int NWAVES = 8;
constexpr int RING_OFF = 0, RING_BYTES = 155648;
constexpr int LDSCTL_OFF = RING_BYTES, MISC_OFF = LDSCTL_OFF + 320;
constexpr int LDS_BYTES = RING_BYTES + 1024;
constexpr int CW_TMO = 0, CW_CODE = 1, CW_BAR = 4096;

struct Frame {
    LAS unsigned char* lds;
    volatile LAS unsigned* MISC;
    gu32* ctl;
    int tid, lane, wave, vcu, G;
    const float *x, *meta, *norm1_w, *w_in, *q_norm_w, *k_norm_w, *sinks, *gate_up, *gate_bias, *gla_norm_w, *w_ab, *w_gb, *w_out, *norm2_w, *r_g, *r_e, *e_wg, *e_wu, *e_wd;
    float* out; unsigned char* ws;
};

#ifdef DIAG_MA
#define DG_MARK(F, id) do { if (blockIdx.x == 0 && (F).tid == 0) (F).MISC[16 + (id)] = (unsigned)__builtin_amdgcn_s_memrealtime(); } while (0)
#else
#define DG_MARK(F, id) do {} while (0)
#endif
__device__ __forceinline__ float wave_sum(float v) {
#pragma unroll
    for (int o = 1; o < 64; o <<= 1) v += __shfl_xor(v, o);
    return v;
}

__device__ __forceinline__ void p0_tr_item(const float* W, int ld, int scol0, bf16_t* WT, int Kdst, int drow0, int k0, LAS float* scr, int lane) {
#pragma unroll 8
    for (int i = 0; i < 32; ++i) { const int kk = 2 * i + (lane >> 5); scr[kk * 33 + (lane & 31)] = W[(size_t)(k0 + kk) * ld + scol0 + (lane & 31)]; }
    LDS_WAIT(); asm volatile("" ::: "memory");
    const int c = lane & 7;
#pragma unroll
    for (int j = 0; j < 4; ++j) { const int n = (lane >> 3) + 8 * j; const LAS float* s = scr + (8 * c) * 33 + n;
        v4u o; o.x = pk2(s[0 * 33], s[1 * 33]); o.y = pk2(s[2 * 33], s[3 * 33]); o.z = pk2(s[4 * 33], s[5 * 33]); o.w = pk2(s[6 * 33], s[7 * 33]);
        *(GAS v4u*)(WT + (size_t)(drow0 + n) * Kdst + k0 + 8 * c) = o; }
    LDS_WAIT(); asm volatile("" ::: "memory");
}
struct TrItem { const float* W; int ld, scol0; bf16_t* WT; int Kdst, drow0, k0; };
__device__ __forceinline__ void p0_tr_item2(const TrItem& a, const TrItem& b, bool has_b, LAS float* scr, int lane) {
    LAS float* s0 = scr; LAS float* s1 = scr + 64 * 33;
    float va[32], vb[32];
#pragma unroll
    for (int i = 0; i < 32; ++i) { const int kk = 2 * i + (lane >> 5); va[i] = a.W[(size_t)(a.k0 + kk) * a.ld + a.scol0 + (lane & 31)]; }
    if (has_b) {
#pragma unroll
        for (int i = 0; i < 32; ++i) { const int kk = 2 * i + (lane >> 5); vb[i] = b.W[(size_t)(b.k0 + kk) * b.ld + b.scol0 + (lane & 31)]; } }
#pragma unroll
    for (int i = 0; i < 32; ++i) { const int kk = 2 * i + (lane >> 5); s0[kk * 33 + (lane & 31)] = va[i]; }
    if (has_b) {
#pragma unroll
        for (int i = 0; i < 32; ++i) { const int kk = 2 * i + (lane >> 5); s1[kk * 33 + (lane & 31)] = vb[i]; } }
    LDS_WAIT(); asm volatile("" ::: "memory");
    const int c = lane & 7;
#pragma unroll
    for (int j = 0; j < 4; ++j) { const int n = (lane >> 3) + 8 * j; const LAS float* s = s0 + (8 * c) * 33 + n;
        v4u o; o.x = pk2(s[0 * 33], s[1 * 33]); o.y = pk2(s[2 * 33], s[3 * 33]); o.z = pk2(s[4 * 33], s[5 * 33]); o.w = pk2(s[6 * 33], s[7 * 33]);
        *(GAS v4u*)(a.WT + (size_t)(a.drow0 + n) * a.Kdst + a.k0 + 8 * c) = o; }
    if (has_b) {
#pragma unroll
        for (int j = 0; j < 4; ++j) { const int n = (lane >> 3) + 8 * j; const LAS float* s = s1 + (8 * c) * 33 + n;
            v4u o; o.x = pk2(s[0 * 33], s[1 * 33]); o.y = pk2(s[2 * 33], s[3 * 33]); o.z = pk2(s[4 * 33], s[5 * 33]); o.w = pk2(s[6 * 33], s[7 * 33]);
            *(GAS v4u*)(b.WT + (size_t)(b.drow0 + n) * b.Kdst + b.k0 + 8 * c) = o; } }
    LDS_WAIT(); asm volatile("" ::: "memory");
}
__device__ __forceinline__ void p0_gk_item(const float* w_in, const float* gate_up, int c0, bf16_t* WT, int drow0, int k0, LAS float* scr, int lane) {
#pragma unroll 4
    for (int i = 0; i < 32; ++i) { const int kk = 2 * i + (lane >> 5); const float* wr = w_in + (size_t)(k0 + kk) * INTOT + OFF_GD; float a = 0.f;
#pragma unroll
        for (int r = 0; r < GR; ++r) a += wr[r] * gate_up[r * 256 + c0 + (lane & 31)];
        scr[kk * 33 + (lane & 31)] = a; }
    LDS_WAIT(); asm volatile("" ::: "memory");
    const int c = lane & 7;
#pragma unroll
    for (int j = 0; j < 4; ++j) { const int n = (lane >> 3) + 8 * j; const LAS float* s = scr + (8 * c) * 33 + n;
        v4u o; o.x = pk2(s[0 * 33], s[1 * 33]); o.y = pk2(s[2 * 33], s[3 * 33]); o.z = pk2(s[4 * 33], s[5 * 33]); o.w = pk2(s[6 * 33], s[7 * 33]);
        *(GAS v4u*)(WT + (size_t)(drow0 + n) * 1024 + k0 + 8 * c) = o; }
    LDS_WAIT(); asm volatile("" ::: "memory");
}
__device__ __forceinline__ int wpt_src_col(int n0) {
    const int tile = n0 >> 8, c = n0 & 255, bj = c >> 7, wc = (c & 127) >> 5;
    if (tile < 2) return OFF_QA + (tile * 4 + wc) * 64 + 32 * bj;
    if (tile == 2) return (wc < 2) ? OFF_KA + wc * 64 + 32 * bj : OFF_VA + (wc - 2) * 64 + 32 * bj;
    if (tile == 3) return OFF_QG + c;
    if (tile == 4) return OFF_KG + c;
    if (tile < 7) return OFF_VG + (tile - 5) * 256 + c;
    if (tile < 9) return OFF_RG + (tile - 7) * 256 + c;
    if (tile == 9) return -1;
    if (tile < 14) return OFF_GA + (tile - 10) * 256 + c;
    return OFF_GG + (tile - 14) * 256 + c;
}
__device__ __forceinline__ void rms_row_to_bf16(const float* xrow, const float* w, bf16_t* orow, int lane) {
    const GAS f32x4* xr = (const GAS f32x4*)xrow + lane; const GAS f32x4* wr = (const GAS f32x4*)w + lane;
    f32x4 v[4]; float s = 0.f;
#pragma unroll
    for (int j = 0; j < 4; ++j) { v[j] = xr[64 * j]; s += (v[j].x * v[j].x + v[j].y * v[j].y) + (v[j].z * v[j].z + v[j].w * v[j].w); }
    const float rstd = rsqrtf(wave_sum(s) * (1.f / D) + EPS);
    GAS unsigned long long* o8 = (GAS unsigned long long*)orow + lane;
#pragma unroll
    for (int j = 0; j < 4; ++j) { const f32x4 ww = wr[64 * j];
        o8[64 * j] = (unsigned long long)pk2(v[j].x * rstd * ww.x, v[j].y * rstd * ww.y) | ((unsigned long long)pk2(v[j].z * rstd * ww.z, v[j].w * rstd * ww.w) << 32); }
}
__device__ __forceinline__ void p0_prologue(Frame& F) {
    LAS float* scr = (LAS float*)(F.lds + RING_OFF + F.wave * 16384);
    const int gw = F.vcu * NWAVES + F.wave, NGW = F.G * NWAVES;
    bf16_t* WpT = (bf16_t*)(F.ws + WS_WPT); bf16_t* WbT = (bf16_t*)(F.ws + WS_WBT); bf16_t* WoT = (bf16_t*)(F.ws + WS_WOT); bf16_t* XN = (bf16_t*)(F.ws + WS_XN);
    constexpr int I_P = 16 * (NP / 32), I_B = 8 * 32, I_O = 16 * 32;
    constexpr int NITEMS = I_P + 2 * I_B + I_O;
    for (int it = gw; it < NITEMS; it += NGW) {
        int r = it;
        if (r < I_P) { const int nb = r >> 4, kb = r & 15, sc = wpt_src_col(nb * 32);
            if (sc >= 0) p0_tr_item(F.w_in, INTOT, sc, WpT, 1024, nb * 32, kb * 64, scr, F.lane);
            else p0_gk_item(F.w_in, F.gate_up, (nb * 32) & 255, WpT, nb * 32, kb * 64, scr, F.lane);
            continue; } r -= I_P;
        if (r < I_B) { p0_tr_item(F.w_ab, 1024, (r >> 3) * 32, WbT, 512, (r >> 3) * 32, (r & 7) * 64, scr, F.lane); continue; } r -= I_B;
        if (r < I_B) { p0_tr_item(F.w_gb, 1024, (r >> 3) * 32, WbT, 512, 1024 + (r >> 3) * 32, (r & 7) * 64, scr, F.lane); continue; } r -= I_B;
        p0_tr_item(F.w_out, 1024, (r >> 4) * 32, WoT, 1024, (r >> 4) * 32, (r & 15) * 64, scr, F.lane);
    }
    for (int m = gw; m < MX; m += 2 * NGW) {
        const int m2 = m + NGW; const bool has2 = m2 < MX;
        const float* s0 = (m < M) ? F.x + (size_t)m * D : F.meta + (size_t)((m < M + NMETA) ? (m - M) : 0) * D;
        const float* s1 = (m2 < M) ? F.x + (size_t)m2 * D : F.meta + (size_t)((has2 && m2 < M + NMETA) ? (m2 - M) : 0) * D;
        const GAS f32x4* x0 = (const GAS f32x4*)s0 + F.lane; const GAS f32x4* x1 = (const GAS f32x4*)s1 + F.lane; const GAS f32x4* wr = (const GAS f32x4*)F.norm1_w + F.lane;
        f32x4 v0[4], v1[4], ww[4]; float a0 = 0.f, a1 = 0.f;
#pragma unroll
        for (int j = 0; j < 4; ++j) { v0[j] = x0[64 * j]; v1[j] = x1[64 * j]; ww[j] = wr[64 * j]; }
#pragma unroll
        for (int j = 0; j < 4; ++j) { a0 += (v0[j].x * v0[j].x + v0[j].y * v0[j].y) + (v0[j].z * v0[j].z + v0[j].w * v0[j].w); a1 += (v1[j].x * v1[j].x + v1[j].y * v1[j].y) + (v1[j].z * v1[j].z + v1[j].w * v1[j].w); }
        float r0 = rsqrtf(wave_sum(a0) * (1.f / D) + EPS), r1 = rsqrtf(wave_sum(a1) * (1.f / D) + EPS);
        if (m >= M + NMETA) r0 = 0.f; if (m2 >= M + NMETA) r1 = 0.f;
        GAS unsigned long long* o0 = (GAS unsigned long long*)(XN + (size_t)m * D) + F.lane; GAS unsigned long long* o1 = (GAS unsigned long long*)(XN + (size_t)m2 * D) + F.lane;
#pragma unroll
        for (int j = 0; j < 4; ++j) {
            o0[64 * j] = (unsigned long long)pk2(v0[j].x * r0 * ww[j].x, v0[j].y * r0 * ww[j].y) | ((unsigned long long)pk2(v0[j].z * r0 * ww[j].z, v0[j].w * r0 * ww[j].w) << 32);
            if (has2) o1[64 * j] = (unsigned long long)pk2(v1[j].x * r1 * ww[j].x, v1[j].y * r1 * ww[j].y) | ((unsigned long long)pk2(v1[j].z * r1 * ww[j].z, v1[j].w * r1 * ww[j].w) << 32); }
    }
    float* rope = (float*)(F.ws + WS_ROPE);
    for (int e = (F.vcu * NWAVES * 64) + F.tid; e < NPOS * 32; e += F.G * NWAVES * 64) {
        const int pos = e >> 5, i = e & 31; const float inv_freq = powf(10000.0f, -((float)(2 * i)) / 64.0f); const float ang = (float)pos * inv_freq;
        rope[2 * e] = cosf(ang); rope[2 * e + 1] = sinf(ang); }
}
__device__ __forceinline__ TrItem expert_item(Frame& F, int r) {
    bf16_t* Wgu = (bf16_t*)(F.ws + WS_WGU); bf16_t* Wd = (bf16_t*)(F.ws + WS_WD);
    constexpr int I_GU = NE * 16 * 16;
    if (r < I_GU) { const int ge = r >> 8, q = r & 255, nb = q >> 4, kb = q & 15;
        const int tn = nb >> 3, bj = (nb >> 2) & 1, qq = nb & 3;
        return TrItem{(bj ? F.e_wu : F.e_wg) + (size_t)ge * D * FF, FF, tn * 128 + qq * 32, Wgu + (size_t)ge * 512 * 1024, 1024, nb * 32, kb * 64}; }
    r -= I_GU;
    const int ge = r >> 7, q = r & 127, nb = q >> 2, kb = q & 3;
    return TrItem{F.e_wd + (size_t)ge * FF * D, D, nb * 32, Wd + (size_t)ge * 1024 * 256, 256, nb * 32, kb * 64};
}
__device__ __forceinline__ void expert_weight_items(Frame& F, int gw, int NGW) {
    LAS float* scr = (LAS float*)(F.lds + RING_OFF + F.wave * 16896);
    constexpr int NIT = NE * 16 * 16 + NE * 4 * 32;
    for (int it = gw; it < NIT; it += 2 * NGW) {
        const bool hb = it + NGW < NIT;
        const TrItem a = expert_item(F, it), b = expert_item(F, hb ? it + NGW : it);
        p0_tr_item2(a, b, hb, scr, F.lane);
    }
}
__device__ __forceinline__ bool attn_valid(int kt, int kr, int i, int qb) {
    if (kt == 0) return kr < 16;
    if (kt < 5) return (qb > 0) && (32 * (kt - 1) + kr > i);
    return 32 * (kt - 5) + kr <= i;
}
__device__ __forceinline__ bool attn_skip(int kt, int i0, int qb) {
    if (kt == 0) return false;
    if (kt < 5) return (qb == 0) || (32 * (kt - 1) + 31 <= i0);
    return 32 * (kt - 5) > i0 + 31;
}
__device__ __forceinline__ void attn_phase(Frame& F) {
    constexpr int KSTR = 144, VSTR = 584;
    LAS unsigned char* Ks = F.lds + RING_OFF; LAS unsigned char* Vt = F.lds + RING_OFF + 288 * KSTR;
    const bf16_t* QA = (const bf16_t*)(F.ws + WS_QA); const bf16_t* KA = (const bf16_t*)(F.ws + WS_KA); const bf16_t* VA = (const bf16_t*)(F.ws + WS_VA); bf16_t* ATT = (bf16_t*)(F.ws + WS_ATT);
    const int lane = F.lane, l31 = lane & 31, hh = lane >> 5;
    for (int u = blockIdx.x; u < 256; u += F.G) {
        const int b = u >> 5, kvh = (u >> 4) & 1, qb = u & 15, m0 = b * S + qb * 128;
        v4u kvr[5], vvr[5];
#pragma unroll
        for (int it = 0; it < 5; ++it) {
            const int idx = F.tid + it * NWAVES * 64, slot = idx >> 3, ch = idx & 7;
            int row = -1;
            if (idx < 288 * 8) { if (slot < 16) row = M + slot; else if (slot >= 160) row = m0 + (slot - 160); else if (slot >= 32 && qb > 0) row = m0 - 128 + (slot - 32); }
            kvr[it] = (v4u){0u, 0u, 0u, 0u}; vvr[it] = (v4u){0u, 0u, 0u, 0u};
            if (row >= 0) { kvr[it] = *(const v4u*)(KA + (size_t)row * 128 + kvh * 64 + ch * 8); vvr[it] = *(const v4u*)(VA + (size_t)row * 128 + kvh * 64 + ch * 8); }
        }
#pragma unroll
        for (int it = 0; it < 5; ++it) {
            const int idx = F.tid + it * NWAVES * 64, slot = idx >> 3, ch = idx & 7;
            if (idx < 288 * 8) {
                *(LAS v4u*)(Ks + slot * KSTR + ch * 16) = kvr[it];
#pragma unroll
                for (int e = 0; e < 8; ++e) { const unsigned w = vvr[it][e >> 1]; *(LAS unsigned short*)(Vt + (8 * ch + e) * VSTR + slot * 2) = (unsigned short)((e & 1) ? (w >> 16) : (w & 0xffffu)); }
            }
        }
        __syncthreads();
        const int g = F.wave >> 1, qh = F.wave & 1, head = kvh * 4 + g;
        const float sink = F.sinks[head];
#pragma unroll 1
        for (int blk = 0; blk < 2; ++blk) {
            const int i0 = 64 * qh + 32 * blk, i = i0 + l31;
            bf16x8 qf[4];
#pragma unroll
            for (int ds = 0; ds < 4; ++ds) qf[ds] = *(const bf16x8*)(QA + (size_t)(m0 + i) * 512 + head * 64 + 16 * ds + 8 * hh);
            float mx = -1e30f;
#pragma unroll
            for (int kt = 0; kt < 9; ++kt) {
                if (attn_skip(kt, i0, qb)) continue;
                f32x16 s = {0.f, 0.f, 0.f, 0.f, 0.f, 0.f, 0.f, 0.f, 0.f, 0.f, 0.f, 0.f, 0.f, 0.f, 0.f, 0.f};
#pragma unroll
                for (int ds = 0; ds < 4; ++ds) { const bf16x8 kf = *(const LAS bf16x8*)(Ks + (32 * kt + l31) * KSTR + (16 * ds + 8 * hh) * 2); s = __builtin_amdgcn_mfma_f32_32x32x16_bf16(kf, qf[ds], s, 0, 0, 0); }
#pragma unroll
                for (int r = 0; r < 16; ++r) { const int kr = (r & 3) + 8 * (r >> 2) + 4 * hh; if (attn_valid(kt, kr, i, qb)) mx = fmaxf(mx, s[r]); }
            }
            mx = fmaxf(mx, __shfl_xor(mx, 32)); mx = fmaxf(mx, sink);
            float lsum = 0.f;
            f32x16 o0 = {0.f, 0.f, 0.f, 0.f, 0.f, 0.f, 0.f, 0.f, 0.f, 0.f, 0.f, 0.f, 0.f, 0.f, 0.f, 0.f}, o1 = o0;
#pragma unroll
            for (int kt = 0; kt < 9; ++kt) {
                if (attn_skip(kt, i0, qb)) continue;
                f32x16 s = {0.f, 0.f, 0.f, 0.f, 0.f, 0.f, 0.f, 0.f, 0.f, 0.f, 0.f, 0.f, 0.f, 0.f, 0.f, 0.f};
#pragma unroll
                for (int ds = 0; ds < 4; ++ds) { const bf16x8 kf = *(const LAS bf16x8*)(Ks + (32 * kt + l31) * KSTR + (16 * ds + 8 * hh) * 2); s = __builtin_amdgcn_mfma_f32_32x32x16_bf16(kf, qf[ds], s, 0, 0, 0); }
                float p[16];
#pragma unroll
                for (int r = 0; r < 16; ++r) { const int kr = (r & 3) + 8 * (r >> 2) + 4 * hh; p[r] = attn_valid(kt, kr, i, qb) ? __expf(s[r] - mx) : 0.f; lsum += p[r]; }
#pragma unroll
                for (int s2 = 0; s2 < 2; ++s2) {
                    v4u pw; pw.x = pg8::cvt_pk_bf16(p[8 * s2 + 0], p[8 * s2 + 1]); pw.y = pg8::cvt_pk_bf16(p[8 * s2 + 2], p[8 * s2 + 3]); pw.z = pg8::cvt_pk_bf16(p[8 * s2 + 4], p[8 * s2 + 5]); pw.w = pg8::cvt_pk_bf16(p[8 * s2 + 6], p[8 * s2 + 7]);
                    const bf16x8 pf = __builtin_bit_cast(bf16x8, pw);
#pragma unroll
                    for (int dt = 0; dt < 2; ++dt) {
                        const LAS unsigned char* vp = Vt + (32 * dt + l31) * VSTR + (32 * kt + 16 * s2 + 4 * hh) * 2;
                        const v2u lo = *(const LAS v2u*)vp, hi = *(const LAS v2u*)(vp + 16);
                        const bf16x8 vf = __builtin_bit_cast(bf16x8, (v4u){lo.x, lo.y, hi.x, hi.y});
                        if (dt == 0) o0 = __builtin_amdgcn_mfma_f32_32x32x16_bf16(vf, pf, o0, 0, 0, 0); else o1 = __builtin_amdgcn_mfma_f32_32x32x16_bf16(vf, pf, o1, 0, 0, 0);
                    }
                }
            }
            lsum += __shfl_xor(lsum, 32); lsum += __expf(sink - mx);
            const float inv = 1.0f / lsum;
            bf16_t* orow = ATT + (size_t)(m0 + i) * 512 + head * 64 + 4 * hh;
#pragma unroll
            for (int rq = 0; rq < 4; ++rq) {
                v2u w0, w1;
                w0.x = pg8::cvt_pk_bf16(o0[4 * rq] * inv, o0[4 * rq + 1] * inv); w0.y = pg8::cvt_pk_bf16(o0[4 * rq + 2] * inv, o0[4 * rq + 3] * inv);
                w1.x = pg8::cvt_pk_bf16(o1[4 * rq] * inv, o1[4 * rq + 1] * inv); w1.y = pg8::cvt_pk_bf16(o1[4 * rq + 2] * inv, o1[4 * rq + 3] * inv);
                *(v2u*)(orow + 8 * rq) = w0; *(v2u*)(orow + 32 + 8 * rq) = w1;
            }
        }
        __syncthreads();
    }
}
__device__ __forceinline__ int crow16(int r, int hh) { return (r & 3) + 8 * (r >> 2) + 4 * hh; }
struct GlaIn { float g[8]; unsigned short q[8], k[8]; v4u vv[2]; };
__device__ __forceinline__ void gla_a_load(Frame& F, int unit, GlaIn& in) {
    const float* GK = (const float*)(F.ws + WS_GK); const bf16_t* QG = (const bf16_t*)(F.ws + WS_QG); const bf16_t* KG = (const bf16_t*)(F.ws + WS_KG); const bf16_t* VG = (const bf16_t*)(F.ws + WS_VG);
    const bool meta = unit >= 1024; const int bh = meta ? 0 : (unit >> 5), c = unit & 31, h = meta ? (unit - 1024) : (bh & 3), b = bh >> 2;
    const int r0 = meta ? (M - 48) : (b * S + 64 * c);
    const int tid = F.tid, d = tid & 63, seg = tid >> 6;
#pragma unroll
    for (int j = 0; j < 8; ++j) { const int t = 8 * seg + j; const bool ok = !meta || t >= 48; const size_t ro = (size_t)(r0 + (ok ? t : 48)) * 256 + h * 64 + d;
        in.g[j] = GK[ro]; in.k[j] = KG[ro]; in.q[j] = meta ? (unsigned short)0 : QG[ro]; }
#pragma unroll
    for (int i = 0; i < 2; ++i) { const int idx = tid + i * NWAVES * 64, t = idx >> 4, ch = idx & 15; const bool ok = !meta || t >= 48;
        in.vv[i] = *(const v4u*)(VG + (size_t)(r0 + (ok ? t : 48)) * 512 + h * 128 + ch * 8); }
}
__device__ __forceinline__ void gla_a_unit(Frame& F, int unit, const GlaIn& in) {
    constexpr int STR = 144;
    LAS unsigned char* Qt = F.lds + RING_OFF; LAS unsigned char* Kt = Qt + 64 * STR; LAS unsigned char* KhT = Kt + 64 * STR; LAS unsigned char* VtT = KhT + 64 * STR;
    LAS float* segsum = (LAS float*)(VtT + 128 * STR); LAS float* gmid = segsum + 512;
    bf16_t* QH = (bf16_t*)(F.ws + WS_QH); float* OI = (float*)(F.ws + WS_OI); float* KV = (float*)(F.ws + WS_KV); float* DEC = (float*)(F.ws + WS_DEC);
    const bool meta = unit >= 1024; const int bh = meta ? 0 : (unit >> 5), c = unit & 31, h = meta ? (unit - 1024) : (bh & 3), b = bh >> 2;
    const int r0 = meta ? (M - 48) : (b * S + 64 * c);
    const int tid = F.tid, d = tid & 63, seg = tid >> 6, lane = F.lane, l31 = lane & 31, hh = lane >> 5;
    float g[8], bb[8]; float run = 0.f;
#pragma unroll
    for (int j = 0; j < 8; ++j) { const int t = 8 * seg + j; const bool ok = !meta || t >= 48; g[j] = ok ? in.g[j] : 0.f; run += g[j]; bb[j] = run; }
    segsum[seg * 64 + d] = run; if (seg == 4) gmid[d] = g[0];
#pragma unroll
    for (int i = 0; i < 2; ++i) { const int idx = tid + i * NWAVES * 64, t = idx >> 4, ch = idx & 15; const bool ok = !meta || t >= 48;
        const v4u vv = ok ? in.vv[i] : (v4u){0u, 0u, 0u, 0u};
#pragma unroll
        for (int e = 0; e < 8; ++e) { const unsigned w = vv[e >> 1]; *(LAS unsigned short*)(VtT + (8 * ch + e) * STR + t * 2) = (unsigned short)((e & 1) ? (w >> 16) : (w & 0xffffu)); } }
    __syncthreads();
    float off = 0.f, tot = 0.f, hsum = 0.f;
#pragma unroll
    for (int s = 0; s < 8; ++s) { const float v = segsum[s * 64 + d]; if (s < seg) off += v; if (s < 4) hsum += v; tot += v; }
    const float bmid = hsum + gmid[d], blast = tot;
#pragma unroll
    for (int j = 0; j < 8; ++j) { const int t = 8 * seg + j; const bool ok = !meta || t >= 48; const float bt = off + bb[j];
        const float q = (ok && !meta) ? bf2f(in.q[j]) : 0.f, k = ok ? bf2f(in.k[j]) : 0.f;
        *(LAS unsigned short*)(Qt + t * STR + d * 2) = (unsigned short)f2bf(q * __expf(bt - bmid));
        *(LAS unsigned short*)(Kt + t * STR + d * 2) = (unsigned short)f2bf(k * __expf(bmid - bt));
        *(LAS unsigned short*)(KhT + d * STR + t * 2) = (unsigned short)f2bf(k * __expf(blast - bt));
        if (!meta) QH[(size_t)(r0 + t) * 256 + h * 64 + d] = (bf16_t)f2bf(q * __expf(bt)); }
    if (seg == 0) DEC[(size_t)unit * 64 + d] = __expf(blast);
    __syncthreads();
    const int w = F.wave, iblk = w & 1, vt = w >> 1;
    if (!meta) {
        f32x16 oacc = {0.f, 0.f, 0.f, 0.f, 0.f, 0.f, 0.f, 0.f, 0.f, 0.f, 0.f, 0.f, 0.f, 0.f, 0.f, 0.f};
#pragma unroll
        for (int jt = 0; jt < 2; ++jt) {
            if (jt > iblk) continue;
            f32x16 a = {0.f, 0.f, 0.f, 0.f, 0.f, 0.f, 0.f, 0.f, 0.f, 0.f, 0.f, 0.f, 0.f, 0.f, 0.f, 0.f};
#pragma unroll
            for (int ds = 0; ds < 4; ++ds) { const bf16x8 kf = *(const LAS bf16x8*)(Kt + (32 * jt + l31) * STR + (16 * ds + 8 * hh) * 2), qf = *(const LAS bf16x8*)(Qt + (32 * iblk + l31) * STR + (16 * ds + 8 * hh) * 2);
                a = __builtin_amdgcn_mfma_f32_32x32x16_bf16(kf, qf, a, 0, 0, 0); }
            if (jt == iblk) {
#pragma unroll
                for (int r = 0; r < 16; ++r) if (crow16(r, hh) > l31) a[r] = 0.f; }
#pragma unroll
            for (int s2 = 0; s2 < 2; ++s2) {
                v4u pw; pw.x = pg8::cvt_pk_bf16(a[8 * s2 + 0], a[8 * s2 + 1]); pw.y = pg8::cvt_pk_bf16(a[8 * s2 + 2], a[8 * s2 + 3]); pw.z = pg8::cvt_pk_bf16(a[8 * s2 + 4], a[8 * s2 + 5]); pw.w = pg8::cvt_pk_bf16(a[8 * s2 + 6], a[8 * s2 + 7]);
                const LAS unsigned char* vp = VtT + (32 * vt + l31) * STR + (32 * jt + 16 * s2 + 4 * hh) * 2;
                const v2u lo = *(const LAS v2u*)vp, hi = *(const LAS v2u*)(vp + 16);
                oacc = __builtin_amdgcn_mfma_f32_32x32x16_bf16(__builtin_bit_cast(bf16x8, (v4u){lo.x, lo.y, hi.x, hi.y}), __builtin_bit_cast(bf16x8, pw), oacc, 0, 0, 0);
            }
        }
        float* op = OI + ((size_t)unit * 8 + w) * 1024 + lane;
#pragma unroll
        for (int r = 0; r < 16; ++r) op[r * 64] = oacc[r];
    }
    {
        const int dblk = w & 1;
        f32x16 kv = {0.f, 0.f, 0.f, 0.f, 0.f, 0.f, 0.f, 0.f, 0.f, 0.f, 0.f, 0.f, 0.f, 0.f, 0.f, 0.f};
#pragma unroll
        for (int s = 0; s < 4; ++s) { const bf16x8 vf = *(const LAS bf16x8*)(VtT + (32 * vt + l31) * STR + (16 * s + 8 * hh) * 2), kf = *(const LAS bf16x8*)(KhT + (32 * dblk + l31) * STR + (16 * s + 8 * hh) * 2);
            kv = __builtin_amdgcn_mfma_f32_32x32x16_bf16(vf, kf, kv, 0, 0, 0); }
        float* kp = KV + (size_t)unit * 8192 + 32 * dblk + l31;
#pragma unroll
        for (int r = 0; r < 16; ++r) kp[(32 * vt + crow16(r, hh)) * 64] = kv[r];
    }
    __syncthreads();
}
__device__ __forceinline__ void gla_scan_phase(Frame& F) {
    typedef float f32x2 __attribute__((ext_vector_type(2)));
    const float* KV = (const float*)(F.ws + WS_KV); const float* DEC = (const float*)(F.ws + WS_DEC); bf16_t* St = (bf16_t*)(F.ws + WS_ST);
    for (int e = F.vcu * NWAVES * 64 + F.tid; e < 32 * 4096; e += F.G * NWAVES * 64) {
        const int bh = e >> 12, p = e & 4095, v = p >> 5, d2 = (p & 31) * 2, h = bh & 3;
        f32x2 s = *(const f32x2*)(KV + (size_t)(1024 + h) * 8192 + v * 64 + d2);
#pragma unroll 1
        for (int cb = 0; cb < 4; ++cb) {
            f32x2 kvv[8], dcv[8];
#pragma unroll
            for (int j = 0; j < 8; ++j) { const size_t unit = (size_t)bh * 32 + cb * 8 + j; dcv[j] = *(const f32x2*)(DEC + unit * 64 + d2); kvv[j] = *(const f32x2*)(KV + unit * 8192 + v * 64 + d2); }
            unsigned st[8];
#pragma unroll
            for (int j = 0; j < 8; ++j) { st[j] = pk2(s.x, s.y); s = dcv[j] * s + kvv[j]; }
#pragma unroll
            for (int j = 0; j < 8; ++j) { const size_t unit = (size_t)bh * 32 + cb * 8 + j; *(unsigned*)(St + unit * 8192 + v * 64 + d2) = st[j]; }
        }
    }
}
__device__ __forceinline__ void gla_c_phase(Frame& F) {
    const bf16_t* QH = (const bf16_t*)(F.ws + WS_QH); const float* OI = (const float*)(F.ws + WS_OI); const bf16_t* St = (const bf16_t*)(F.ws + WS_ST); const bf16_t* RG = (const bf16_t*)(F.ws + WS_RG);
    bf16_t* OG = (bf16_t*)(F.ws + WS_OG);
    const int lane = F.lane, l31 = lane & 31, hh = lane >> 5, w = F.wave;
    f32x4 w4v[4][4];
#pragma unroll
    for (int vt = 0; vt < 4; ++vt)
#pragma unroll
        for (int rq = 0; rq < 4; ++rq) w4v[vt][rq] = *(const f32x4*)(F.gla_norm_w + 32 * vt + 8 * rq + 4 * hh);
    for (int u = blockIdx.x; u < 256; u += F.G) {
        const int bh = u >> 3, cg = u & 7, b = bh >> 2, h = bh & 3, c = 4 * cg + (w >> 1), iblk = w & 1;
        const size_t unit = (size_t)bh * 32 + c; const int row = b * S + 64 * c + 32 * iblk + l31;
        bf16x8 qf[4];
#pragma unroll
        for (int s = 0; s < 4; ++s) qf[s] = *(const bf16x8*)(QH + (size_t)row * 256 + h * 64 + 16 * s + 8 * hh);
        f32x16 acc[4]; float ss = 0.f;
#pragma unroll
        for (int vt = 0; vt < 4; ++vt) {
            const float* op = OI + (unit * 8 + vt * 2 + iblk) * 1024 + lane;
#pragma unroll
            for (int r = 0; r < 16; ++r) acc[vt][r] = op[r * 64];
#pragma unroll
            for (int s = 0; s < 4; ++s) { const bf16x8 sf = *(const bf16x8*)(St + unit * 8192 + (32 * vt + l31) * 64 + 16 * s + 8 * hh); acc[vt] = __builtin_amdgcn_mfma_f32_32x32x16_bf16(sf, qf[s], acc[vt], 0, 0, 0); }
#pragma unroll
            for (int r = 0; r < 16; ++r) ss += acc[vt][r] * acc[vt][r];
        }
        ss += __shfl_xor(ss, 32);
        const float rstd = rsqrtf(ss * (1.0f / 128.0f) + EPS);
        v2u rgv[4][4];
#pragma unroll
        for (int vt = 0; vt < 4; ++vt)
#pragma unroll
            for (int rq = 0; rq < 4; ++rq) rgv[vt][rq] = *(const v2u*)(RG + (size_t)row * 512 + h * 128 + 32 * vt + 8 * rq + 4 * hh);
#pragma unroll
        for (int vt = 0; vt < 4; ++vt)
#pragma unroll
            for (int rq = 0; rq < 4; ++rq) { const int v0 = 32 * vt + 8 * rq + 4 * hh;
                const f32x4 w4 = w4v[vt][rq]; const v2u rg = rgv[vt][rq];
                const float o0 = acc[vt][4 * rq + 0] * rstd * w4[0] * __builtin_bit_cast(float, rg.x << 16), o1 = acc[vt][4 * rq + 1] * rstd * w4[1] * __builtin_bit_cast(float, rg.x & 0xffff0000u);
                const float o2 = acc[vt][4 * rq + 2] * rstd * w4[2] * __builtin_bit_cast(float, rg.y << 16), o3 = acc[vt][4 * rq + 3] * rstd * w4[3] * __builtin_bit_cast(float, rg.y & 0xffff0000u);
                v2u o; o.x = pg8::cvt_pk_bf16(o0, o1); o.y = pg8::cvt_pk_bf16(o2, o3);
                *(v2u*)(OG + (size_t)row * 512 + h * 128 + v0) = o; }
    }
}
constexpr size_t WS_WRT = WS_ROPE + 640 * 1024;
constexpr size_t WS_XN2 = WS_MG;
constexpr size_t WS_HID = WS_RG;
constexpr size_t WS_EL  = WS_GK;
constexpr size_t WS_EW  = WS_EL + 2 * MiB;
constexpr size_t WS_PL  = WS_EW + 2 * MiB;
constexpr size_t WS_TI  = WS_PL + 7 * MiB;
static_assert(WS_TI + (size_t)M * 4 <= WS_ATT, "MoE lists inside the dead GK region");
constexpr int CW_ECNT = 12288, CSTR = 32;
constexpr int LCAP = 16384;

__device__ __forceinline__ void p0_router_weights(Frame& F) {
    bf16_t* Whi = (bf16_t*)(F.ws + WS_WRT); bf16_t* Wlo = Whi + 48 * 1024;
    for (int e = F.vcu * NWAVES * 64 + F.tid; e < 48 * 1024; e += F.G * NWAVES * 64) {
        const int n = e >> 10, d = e & 1023; float v = 0.f;
        if (n < 4) v = F.r_g[(size_t)d * NG + n]; else if (n < 36) { const int g = (n - 4) >> 3, ex = (n - 4) & 7; v = F.r_e[((size_t)g * D + d) * EPG + ex]; }
        v *= F.norm2_w[d];
        const unsigned hi = f2bf(v); const float rem = v - __builtin_bit_cast(float, hi << 16);
        Whi[e] = (bf16_t)hi; Wlo[e] = (bf16_t)f2bf(rem); }
}
__device__ __forceinline__ void router_phase(Frame& F) {
    LAS float* lg = (LAS float*)(F.lds + RING_OFF);
    LAS float* lgs = lg + 8 * 64 * 48;
    LAS float* ssq = lgs + 64 * 48;
    LAS int* hist = (LAS int*)(ssq + 512);
    LAS int* base = hist + 144;
    LAS float* rstd_s = (LAS float*)(base + 144);
    const float* WrT = (const float*)(F.ws + WS_WRT); const float* H = F.out; bf16_t* XN2 = (bf16_t*)(F.ws + WS_XN2);
    int* EL = (int*)(F.ws + WS_EL); float* EW = (float*)(F.ws + WS_EW); int* PL = (int*)(F.ws + WS_PL); int* TI = (int*)(F.ws + WS_TI);
    unsigned* gcnt = (unsigned*)(F.ctl + CW_ECNT);
    const int tid = F.tid, lane = F.lane, w = F.wave;
    for (int tile = blockIdx.x; tile < M / 64; tile += F.G) {
        const int t0 = tile * 64;
        DG_MARK(F, 0);
        if (tid < 144) hist[tid] = 0;
        {
            const int tk = lane & 15, q = lane >> 4;
            const float* hp = H + (size_t)(t0 + tk) * D + 128 * w + 8 * q;
            const bf16_t* whp = (const bf16_t*)(F.ws + WS_WRT) + (size_t)tk * D + 128 * w + 8 * q; const bf16_t* wlp = whp + 48 * 1024;
            f32x4 acc[4][3]; float ss[4];
#pragma unroll
            for (int tt = 0; tt < 4; ++tt) { ss[tt] = 0.f;
#pragma unroll
                for (int nt = 0; nt < 3; ++nt) acc[tt][nt] = (f32x4){0.f, 0.f, 0.f, 0.f}; }
#pragma unroll 2
            for (int ks = 0; ks < 4; ++ks) {
                bf16x8 wh[3], wl[3]; f32x4 hv[4][2];
#pragma unroll
                for (int nt = 0; nt < 3; ++nt) { wh[nt] = *(const bf16x8*)(whp + nt * 16 * D + 32 * ks); wl[nt] = *(const bf16x8*)(wlp + nt * 16 * D + 32 * ks); }
#pragma unroll
                for (int tt = 0; tt < 4; ++tt) { hv[tt][0] = *(const f32x4*)(hp + (size_t)tt * 16 * D + 32 * ks); hv[tt][1] = *(const f32x4*)(hp + (size_t)tt * 16 * D + 32 * ks + 4); }
#pragma unroll
                for (int tt = 0; tt < 4; ++tt) {
                    const f32x4 x0 = hv[tt][0], x1 = hv[tt][1];
                    ss[tt] += (x0[0] * x0[0] + x0[1] * x0[1]) + (x0[2] * x0[2] + x0[3] * x0[3]) + (x1[0] * x1[0] + x1[1] * x1[1]) + (x1[2] * x1[2] + x1[3] * x1[3]);
                    unsigned hb[8]; float lo[8];
#pragma unroll
                    for (int e = 0; e < 4; ++e) { hb[e] = f2bf(x0[e]); lo[e] = x0[e] - __builtin_bit_cast(float, hb[e] << 16); hb[4 + e] = f2bf(x1[e]); lo[4 + e] = x1[e] - __builtin_bit_cast(float, hb[4 + e] << 16); }
                    v4u hw, lw;
                    hw.x = hb[0] | (hb[1] << 16); hw.y = hb[2] | (hb[3] << 16); hw.z = hb[4] | (hb[5] << 16); hw.w = hb[6] | (hb[7] << 16);
                    lw.x = pk2(lo[0], lo[1]); lw.y = pk2(lo[2], lo[3]); lw.z = pk2(lo[4], lo[5]); lw.w = pk2(lo[6], lo[7]);
                    const bf16x8 hh8 = __builtin_bit_cast(bf16x8, hw), hl8 = __builtin_bit_cast(bf16x8, lw);
#pragma unroll
                    for (int nt = 0; nt < 3; ++nt) {
                        acc[tt][nt] = __builtin_amdgcn_mfma_f32_16x16x32_bf16(wh[nt], hh8, acc[tt][nt], 0, 0, 0);
                        acc[tt][nt] = __builtin_amdgcn_mfma_f32_16x16x32_bf16(wh[nt], hl8, acc[tt][nt], 0, 0, 0);
                        acc[tt][nt] = __builtin_amdgcn_mfma_f32_16x16x32_bf16(wl[nt], hh8, acc[tt][nt], 0, 0, 0); }
                }
            }
#pragma unroll
            for (int tt = 0; tt < 4; ++tt) {
                float s1 = ss[tt]; s1 += __shfl_xor(s1, 16); s1 += __shfl_xor(s1, 32);
                if (q == 0) ssq[w * 64 + 16 * tt + tk] = s1;
                LAS float* lp = lg + (w * 64 + 16 * tt + tk) * 48 + 4 * q;
#pragma unroll
                for (int nt = 0; nt < 3; ++nt)
#pragma unroll
                    for (int r = 0; r < 4; ++r) lp[16 * nt + r] = acc[tt][nt][r];
            }
        }
        __syncthreads();
        {
            const int token = tid & 63, part = tid >> 6;
#pragma unroll
            for (int i = 0; i < 6; ++i) { float a = 0.f;
#pragma unroll
                for (int ww = 0; ww < 8; ++ww) a += lg[(ww * 64 + token) * 48 + 6 * part + i];
                lgs[token * 48 + 6 * part + i] = a; }
            if (part == 0) { float a = 0.f;
#pragma unroll
                for (int ww = 0; ww < 8; ++ww) a += ssq[ww * 64 + token];
                ssq[token] = a; }
        }
        __syncthreads();
        DG_MARK(F, 1);
        int ge_lo = 0, ge_hi = 0, pr = 0, rk_lo = 0, rk_hi = 0, rk_p = 0; float w_lo = 0.f, w_hi = 0.f;
        if (tid < 64) {
            const float rs = rsqrtf(ssq[tid] * (1.0f / D) + EPS); rstd_s[tid] = rs;
            const LAS float* l0 = lgs + tid * 48;
            int g = 0; float mx = l0[0] * rs; float gl[4]; gl[0] = mx;
#pragma unroll
            for (int i = 1; i < 4; ++i) { gl[i] = l0[i] * rs; if (gl[i] > mx) { mx = gl[i]; g = i; } }
            float den = 0.f;
#pragma unroll
            for (int i = 0; i < 4; ++i) den += expf(gl[i] - mx);
            const float gw = 1.0f / den;
            int e1 = 0; float v1 = l0[4 + 8 * g] * rs; float el[8]; el[0] = v1;
#pragma unroll
            for (int i = 1; i < 8; ++i) { el[i] = l0[4 + 8 * g + i] * rs; if (el[i] > v1) { v1 = el[i]; e1 = i; } }
            int e2 = -1; float v2 = -3.0e38f;
#pragma unroll
            for (int i = 0; i < 8; ++i) if (i != e1 && el[i] > v2) { v2 = el[i]; e2 = i; }
            const float p2 = expf(v2 - v1), dn = 1.0f / (1.0f + p2); const float w1 = gw * dn, w2 = gw * p2 * dn;
            const int elo = e1 < e2 ? e1 : e2, ehi = e1 < e2 ? e2 : e1; w_lo = e1 < e2 ? w1 : w2; w_hi = e1 < e2 ? w2 : w1;
            ge_lo = 8 * g + elo; ge_hi = 8 * g + ehi; pr = g * 28 + (elo * (15 - elo)) / 2 + (ehi - elo - 1);
            rk_lo = atomicAdd((int*)(hist + ge_lo), 1); rk_hi = atomicAdd((int*)(hist + ge_hi), 1); rk_p = atomicAdd((int*)(hist + 32 + pr), 1);
        }
        __syncthreads();
        if (tid < 144) { const int c = hist[tid]; base[tid] = c ? (int)atomicAdd(gcnt + CSTR * tid, (unsigned)c) : 0; }
        __syncthreads();
        if (tid < 64) {
            const int token = t0 + tid;
            const int plo = base[ge_lo] + rk_lo, phi = base[ge_hi] + rk_hi, pp = base[32 + pr] + rk_p;
            EL[(size_t)ge_lo * LCAP + plo] = token; EW[(size_t)ge_lo * LCAP + plo] = w_lo;
            EL[(size_t)ge_hi * LCAP + phi] = token | (1 << 16); EW[(size_t)ge_hi * LCAP + phi] = w_hi;
            PL[(size_t)pr * LCAP + pp] = token; TI[token] = ge_lo | (ge_hi << 8);
        }
        DG_MARK(F, 2);
        {
            const f32x4* wr = (const f32x4*)F.norm2_w + lane; f32x4 ww[4];
#pragma unroll
            for (int j = 0; j < 4; ++j) ww[j] = wr[64 * j];
#pragma unroll 1
            for (int i = w; i < 64; i += 4 * NWAVES) {
                f32x4 v[4][4];
#pragma unroll
                for (int q = 0; q < 4; ++q) { const f32x4* xr = (const f32x4*)(H + (size_t)(t0 + i + 8 * q) * D) + lane;
#pragma unroll
                    for (int j = 0; j < 4; ++j) v[q][j] = xr[64 * j]; }
#pragma unroll
                for (int q = 0; q < 4; ++q) { const float rs = rstd_s[i + 8 * q]; unsigned long long* o8 = (unsigned long long*)(XN2 + (size_t)(t0 + i + 8 * q) * D) + lane;
#pragma unroll
                    for (int j = 0; j < 4; ++j) o8[64 * j] = (unsigned long long)pk2(v[q][j][0] * rs * ww[j][0], v[q][j][1] * rs * ww[j][1]) | ((unsigned long long)pk2(v[q][j][2] * rs * ww[j][2], v[q][j][3] * rs * ww[j][3]) << 32); }
            }
        }
        __syncthreads();
        DG_MARK(F, 3);
    }
}
namespace mg {
constexpr int BUFB = 49152, NBUF = 3, INFO_OFF = NBUF * BUFB;
template <bool PERM, class BSel, class Epi>
__device__ __forceinline__ void tile(LAS unsigned char* lds, const bf16_t* A, int lda, int ldb, int nk, int nseg, const BSel& Bsel, const Epi& E) {
    const int tid = threadIdx.x, wid = __builtin_amdgcn_readfirstlane(tid >> 6), lane = tid & 63, wr = wid >> 2, wc = wid & 3, fr = lane & 15, fq = lane >> 4;
    const LAS int* rows = (const LAS int*)(lds + INFO_OFF);
    unsigned aoffv[2], boffv[2];
#pragma unroll
    for (int i = 0; i < 2; ++i) { int R, C; pg8::stage_rc(tid * 16 + i * 8192, R, C); const int Rb = PERM ? ((R & ~31) + pg8::perm32(R & 31)) : R;
        aoffv[i] = (unsigned)(rows[R] * lda + C) * 2u; boffv[i] = (unsigned)(Rb * ldb + C) * 2u; }
    const unsigned ldsw = (unsigned)wid * 1024u; const size_t bhalf = (size_t)128 * ldb * 2;
    const int aoff = pg8::lds_byte(wr * 64 + fr, fq * 8), boff = pg8::lds_byte(wc * 32 + fr, fq * 8);
    const int nsteps = nk * nseg;
#define MG_STAGE(j) do { const int sg_ = (j) / nk, kt_ = (j) - sg_ * nk, b_ = (j) % NBUF; const char* ap_ = (const char*)A + (size_t)kt_ * 128; const char* bp_ = (const char*)Bsel(sg_, kt_); \
        _Pragma("unroll") for (int i_ = 0; i_ < 2; ++i_) __builtin_amdgcn_global_load_lds((const unsigned*)(ap_ + aoffv[i_]), (LAS unsigned*)(lds + b_ * BUFB + ldsw + i_ * 8192), 16, 0, 0); \
        _Pragma("unroll") for (int h_ = 0; h_ < 2; ++h_) _Pragma("unroll") for (int i_ = 0; i_ < 2; ++i_) \
            __builtin_amdgcn_global_load_lds((const unsigned*)(bp_ + h_ * bhalf + boffv[i_]), (LAS unsigned*)(lds + b_ * BUFB + 16384 + h_ * 16384 + ldsw + i_ * 8192), 16, 0, 0); } while (0)
    f32x4 acc[2][4][2];
#pragma unroll
    for (int b = 0; b < 2; ++b)
#pragma unroll
        for (int m = 0; m < 4; ++m)
#pragma unroll
            for (int n = 0; n < 2; ++n) acc[b][m][n] = (f32x4){0.f, 0.f, 0.f, 0.f};
    MG_STAGE(0); MG_STAGE(1);
    int kseg = 0, sg = 0;
    for (int j = 0; j < nsteps; ++j) {
        const int cb = j % NBUF;
        if (j + 1 < nsteps) asm volatile("s_waitcnt vmcnt(6)" ::: "memory"); else asm volatile("s_waitcnt vmcnt(0)" ::: "memory");
        __builtin_amdgcn_s_barrier(); __builtin_amdgcn_sched_barrier(0);
        if (j + 2 < nsteps) MG_STAGE(j + 2);
        bf16x8 At[4][2], Bt[2][2][2];
        const LAS unsigned char* pa = lds + cb * BUFB + aoff; const LAS unsigned char* pb = lds + cb * BUFB + 16384 + boff;
#pragma unroll
        for (int m = 0; m < 4; ++m)
#pragma unroll
            for (int k = 0; k < 2; ++k) At[m][k] = *(const LAS bf16x8*)(pa + m * 2048 + k * 1024);
#pragma unroll
        for (int bj = 0; bj < 2; ++bj)
#pragma unroll
            for (int n = 0; n < 2; ++n)
#pragma unroll
                for (int k = 0; k < 2; ++k) Bt[bj][n][k] = *(const LAS bf16x8*)(pb + bj * 16384 + n * 2048 + k * 1024);
        __builtin_amdgcn_s_setprio(1);
#pragma unroll
        for (int bj = 0; bj < 2; ++bj)
#pragma unroll
            for (int m = 0; m < 4; ++m)
#pragma unroll
                for (int n = 0; n < 2; ++n)
#pragma unroll
                    for (int k = 0; k < 2; ++k) acc[bj][m][n] = __builtin_amdgcn_mfma_f32_16x16x32_bf16(Bt[bj][n][k], At[m][k], acc[bj][m][n], 0, 0, 0);
        __builtin_amdgcn_s_setprio(0);
        __builtin_amdgcn_sched_barrier(0);
        if (++kseg == nk) {
            E(acc, sg, wr, wc, fr, fq); kseg = 0; ++sg;
#pragma unroll
            for (int b = 0; b < 2; ++b)
#pragma unroll
                for (int m = 0; m < 4; ++m)
#pragma unroll
                    for (int n = 0; n < 2; ++n) acc[b][m][n] = (f32x4){0.f, 0.f, 0.f, 0.f};
        }
    }
#undef MG_STAGE
    asm volatile("s_waitcnt lgkmcnt(0)" ::: "memory"); __builtin_amdgcn_s_barrier();
}
}

struct EpiMoe1 {
    LAS unsigned char* lds; bf16_t* HID; int tn, nvalid;
    __device__ __forceinline__ void operator()(const f32x4 (&acc)[2][4][2], int sg, int wr, int wc, int fr, int fq) const {
        const LAS int* rows = (const LAS int*)(lds + mg::INFO_OFF); const LAS float* wts = (const LAS float*)(lds + mg::INFO_OFF + 512); const LAS int* aux = (const LAS int*)(lds + mg::INFO_OFF + 1024);
#pragma unroll
        for (int m = 0; m < 4; ++m) { const int r = wr * 64 + m * 16 + fr; if (r >= nvalid) continue;
            const float cw = wts[r]; f32x4 h0, h1;
#pragma unroll
            for (int j = 0; j < 4; ++j) { const float g0 = acc[0][m][0][j], g1 = acc[0][m][1][j]; h0[j] = g0 * fast_sigmoid(g0) * acc[1][m][0][j] * cw; h1[j] = g1 * fast_sigmoid(g1) * acc[1][m][1][j] * cw; }
            *(v4u*)(HID + (size_t)rows[r] * 512 + aux[r] * 256 + tn * 128 + wc * 32 + 8 * fq) = pg8::pack8(h0, h1); }
    }
};
struct EpiMoe2 {
    LAS unsigned char* lds; float* O; int nvalid;
    __device__ __forceinline__ void operator()(const f32x4 (&acc)[2][4][2], int tn, int wr, int wc, int fr, int fq) const {
        const LAS int* rows = (const LAS int*)(lds + mg::INFO_OFF);
        f32x4 hv[4][2][2];
#pragma unroll
        for (int m = 0; m < 4; ++m) { const int r = wr * 64 + m * 16 + fr; const float* op = O + (size_t)rows[r] * D + tn * 256 + wc * 32 + 4 * fq;
#pragma unroll
            for (int bj = 0; bj < 2; ++bj)
#pragma unroll
                for (int n = 0; n < 2; ++n) hv[m][bj][n] = *(const f32x4*)(op + bj * 128 + n * 16); }
#pragma unroll
        for (int m = 0; m < 4; ++m) { const int r = wr * 64 + m * 16 + fr; if (r >= nvalid) continue;
            float* op = O + (size_t)rows[r] * D + tn * 256 + wc * 32 + 4 * fq;
#pragma unroll
            for (int bj = 0; bj < 2; ++bj)
#pragma unroll
                for (int n = 0; n < 2; ++n) *(f32x4*)(op + bj * 128 + n * 16) = hv[m][bj][n] + acc[bj][m][n]; }
    }
};
__device__ __forceinline__ void moe1_phase(Frame& F) {
    LAS unsigned char* lds = F.lds + RING_OFF;
    LAS int* pre = (LAS int*)(lds + mg::INFO_OFF + 2048);
    const unsigned* gcnt = (const unsigned*)(F.ctl + CW_ECNT);
    const int* EL = (const int*)(F.ws + WS_EL); const float* EW = (const float*)(F.ws + WS_EW);
    if (F.tid == 0) { int a = 0; for (int e = 0; e < NE; ++e) { pre[e] = a; a += (((int)gcnt[CSTR * e] + 127) >> 7) * 2; } pre[NE] = a; }
    __syncthreads();
    const int total = pre[NE];
    for (int u = F.vcu; u < total; u += F.G) {
        int e = 0; while (e < NE - 1 && u >= pre[e + 1]) ++e;
        const int q = u - pre[e], mt = q >> 1, tn = q & 1, cnt = (int)gcnt[CSTR * e], nvalid = (cnt - mt * 128 < 128) ? (cnt - mt * 128) : 128;
        __syncthreads();
        if (F.tid < 128) { const int idx = mt * 128 + ((F.tid < nvalid) ? F.tid : 0); const int ent = EL[(size_t)e * LCAP + idx];
            ((LAS int*)(lds + mg::INFO_OFF))[F.tid] = ent & 0xffff; ((LAS float*)(lds + mg::INFO_OFF + 512))[F.tid] = EW[(size_t)e * LCAP + idx]; ((LAS int*)(lds + mg::INFO_OFF + 1024))[F.tid] = ent >> 16; }
        __syncthreads();
        const bf16_t* Bp = (const bf16_t*)(F.ws + WS_WGU) + (size_t)e * 512 * 1024 + (size_t)tn * 256 * 1024;
        EpiMoe1 E{lds, (bf16_t*)(F.ws + WS_HID), tn, nvalid};
        auto bsel = [Bp](int, int kt) { return Bp + (size_t)kt * 64; };
        mg::tile<true>(lds, (const bf16_t*)(F.ws + WS_XN2), D, 1024, 16, 1, bsel, E);
    }
    __syncthreads();
}
__device__ __forceinline__ void moe2_phase(Frame& F) {
    LAS unsigned char* lds = F.lds + RING_OFF;
    LAS int* pre = (LAS int*)(lds + mg::INFO_OFF + 2048);
    const unsigned* pcnt = (const unsigned*)(F.ctl + CW_ECNT) + CSTR * 32;
    const int* PL = (const int*)(F.ws + WS_PL);
    if (F.tid == 0) { int a = 0; for (int p = 0; p < 112; ++p) { pre[p] = a; a += (((int)pcnt[CSTR * p] + 127) >> 7); } pre[112] = a; }
    __syncthreads();
    const int total = pre[112];
    for (int u = F.vcu; u < total; u += F.G) {
        int p = 0; while (p < 111 && u >= pre[p + 1]) ++p;
        const int mt = u - pre[p], cnt = (int)pcnt[CSTR * p], nvalid = (cnt - mt * 128 < 128) ? (cnt - mt * 128) : 128;
        const int g = p / 28; int pi = p - g * 28, elo = 0; while (pi >= 7 - elo) { pi -= 7 - elo; ++elo; } const int ehi = elo + 1 + pi;
        __syncthreads();
        if (F.tid < 128) ((LAS int*)(lds + mg::INFO_OFF))[F.tid] = PL[(size_t)p * LCAP + mt * 128 + ((F.tid < nvalid) ? F.tid : 0)];
        __syncthreads();
        const bf16_t* B0 = (const bf16_t*)(F.ws + WS_WD) + (size_t)(8 * g + elo) * 1024 * 256;
        const bf16_t* B1 = (const bf16_t*)(F.ws + WS_WD) + (size_t)(8 * g + ehi) * 1024 * 256;
        EpiMoe2 E{lds, F.out, nvalid};
        auto bsel = [B0, B1](int tn, int kt) { return (kt < 4 ? B0 + (size_t)kt * 64 : B1 + (size_t)(kt - 4) * 64) + (size_t)tn * 256 * 256; };
        mg::tile<false>(lds, (const bf16_t*)(F.ws + WS_HID), 512, 256, 8, 4, bsel, E);
    }
    __syncthreads();
}
__global__ void __launch_bounds__(64) s_attn(const bf16_t* __restrict__ QA, const bf16_t* __restrict__ KA, const bf16_t* __restrict__ VA, const float* __restrict__ sinks, bf16_t* __restrict__ ATT) {
    const int m = blockIdx.x, h = blockIdx.y, kvh = h >> 2, lane = threadIdx.x, s = m & (S - 1);
    __shared__ float q[64]; __shared__ float sc[160];
    q[lane] = bf2f(QA[(size_t)m * 512 + h * 64 + lane]);
    __syncthreads();
    const int j0 = (s - 127 > 0) ? (s - 127) : 0; const int nband = s - j0 + 1, nk = NMETA + nband;
    for (int i = lane; i < nk; i += 64) {
        const int kr = (i < NMETA) ? (M + i) : (m - s + j0 + (i - NMETA));
        const bf16_t* kp = KA + (size_t)kr * 128 + kvh * 64;
        float a = 0.f;
        for (int d = 0; d < 64; ++d) a += q[d] * bf2f(kp[d]);
        sc[i] = a;
    }
    __syncthreads();
    const float sk = sinks[h];
    float mx = sk;
    for (int i = 0; i < nk; ++i) mx = fmaxf(mx, sc[i]);
    float den = expf(sk - mx), o = 0.f;
    for (int i = 0; i < nk; ++i) {
        const int kr = (i < NMETA) ? (M + i) : (m - s + j0 + (i - NMETA));
        const float p = expf(sc[i] - mx); den += p; o += p * bf2f(VA[(size_t)kr * 128 + kvh * 64 + lane]);
    }
    ATT[(size_t)m * 512 + h * 64 + lane] = (bf16_t)f2bf(o / den);
}
__global__ void __launch_bounds__(128) s_gla(const bf16_t* __restrict__ QG, const bf16_t* __restrict__ KG, const bf16_t* __restrict__ VG, const float* __restrict__ GK, float* __restrict__ O) {
    const int b = blockIdx.x >> 2, h = blockIdx.x & 3, v = threadIdx.x;
    __shared__ float sq[64], sk[64], sg[64];
    float St[64];
#pragma unroll
    for (int d = 0; d < 64; ++d) St[d] = 0.f;
    for (int t = 0; t < NMETA + S; ++t) {
        const int row = (t < NMETA) ? (M + t) : (b * S + (t - NMETA));
        if (v < 64) { sq[v] = (t < NMETA) ? 0.f : bf2f(QG[(size_t)row * 256 + h * 64 + v]); sk[v] = bf2f(KG[(size_t)row * 256 + h * 64 + v]); sg[v] = expf(GK[(size_t)row * 256 + h * 64 + v]); }
        __syncthreads();
        const float vv = bf2f(VG[(size_t)row * 512 + h * 128 + v]);
        float acc = 0.f;
#pragma unroll
        for (int d = 0; d < 64; ++d) { St[d] = sg[d] * St[d] + sk[d] * vv; acc += sq[d] * St[d]; }
        if (t >= NMETA) O[(size_t)row * 512 + h * 128 + v] = acc;
        __syncthreads();
    }
}
__global__ void __launch_bounds__(128) s_gla_out(const float* __restrict__ O, const bf16_t* __restrict__ RG, const float* __restrict__ w, bf16_t* __restrict__ OG) {
    const int m = blockIdx.x, h = blockIdx.y, v = threadIdx.x;
    __shared__ float red[2];
    const float x = O[(size_t)m * 512 + h * 128 + v];
    float s = x * x;
#pragma unroll
    for (int of = 1; of < 64; of <<= 1) s += __shfl_xor(s, of);
    if ((v & 63) == 0) red[v >> 6] = s;
    __syncthreads();
    const float r = rsqrtf((red[0] + red[1]) / 128.f + EPS);
    OG[(size_t)m * 512 + h * 128 + v] = (bf16_t)f2bf(x * r * w[v] * bf2f(RG[(size_t)m * 512 + h * 128 + v]));
}
__global__ void __launch_bounds__(256) s_moe(const float* __restrict__ norm2_w, const float* __restrict__ rg, const float* __restrict__ re,
                                             const float* __restrict__ wg, const float* __restrict__ wu, const float* __restrict__ wd, float* __restrict__ out) {
    const int t = blockIdx.x, tid = threadIdx.x;
    __shared__ float xn[D]; __shared__ float red[256]; __shared__ float logits[36]; __shared__ float hid[FF]; __shared__ int sel[3]; __shared__ float selw[2];
    float* hr = out + (size_t)t * D;
    float hv4[4]; float s = 0.f;
#pragma unroll
    for (int j = 0; j < 4; ++j) { hv4[j] = hr[tid + 256 * j]; s += hv4[j] * hv4[j]; }
    red[tid] = s; __syncthreads();
    for (int o = 128; o > 0; o >>= 1) { if (tid < o) red[tid] += red[tid + o]; __syncthreads(); }
    const float r = rsqrtf(red[0] / (float)D + EPS);
#pragma unroll
    for (int j = 0; j < 4; ++j) xn[tid + 256 * j] = hv4[j] * r * norm2_w[tid + 256 * j];
    __syncthreads();
    if (tid < 36) {
        float a = 0.f;
        if (tid < 4) { for (int d = 0; d < D; ++d) a += xn[d] * rg[(size_t)d * NG + tid]; }
        else { const int g = (tid - 4) >> 3, e = (tid - 4) & 7; for (int d = 0; d < D; ++d) a += xn[d] * re[((size_t)g * D + d) * EPG + e]; }
        logits[tid] = a;
    }
    __syncthreads();
    if (tid == 0) {
        int g = 0; float mx = logits[0];
        for (int i = 1; i < NG; ++i) if (logits[i] > mx) { mx = logits[i]; g = i; }
        float den = 0.f; for (int i = 0; i < NG; ++i) den += expf(logits[i] - mx);
        const float gw = 1.f / den;
        const float* el = logits + 4 + g * 8;
        int e1 = 0; float v1 = el[0];
        for (int i = 1; i < EPG; ++i) if (el[i] > v1) { v1 = el[i]; e1 = i; }
        int e2 = -1; float v2 = -3.0e38f;
        for (int i = 0; i < EPG; ++i) if (i != e1 && el[i] > v2) { v2 = el[i]; e2 = i; }
        const float p2 = expf(v2 - v1), dn = 1.f + p2;
        sel[0] = g; sel[1] = e1; sel[2] = e2; selw[0] = gw / dn; selw[1] = gw * p2 / dn;
    }
    __syncthreads();
    float y[4] = {0.f, 0.f, 0.f, 0.f};
    const int g = sel[0];
    for (int kk = 0; kk < 2; ++kk) {
        const int e = sel[1 + kk]; const float cw = selw[kk];
        const float* pg = wg + ((size_t)(g * EPG + e) * D) * FF + tid;
        const float* pu = wu + ((size_t)(g * EPG + e) * D) * FF + tid;
        float ag = 0.f, au = 0.f;
        for (int d = 0; d < D; ++d) { const float xv = xn[d]; ag += xv * pg[(size_t)d * FF]; au += xv * pu[(size_t)d * FF]; }
        __syncthreads();
        hid[tid] = silu_f(ag) * au * cw;
        __syncthreads();
        const float* pd = wd + ((size_t)(g * EPG + e) * FF) * D;
        for (int f = 0; f < FF; ++f) { const float hv = hid[f];
#pragma unroll
            for (int j = 0; j < 4; ++j) y[j] += hv * pd[(size_t)f * D + tid + 256 * j]; }
    }
#pragma unroll
    for (int j = 0; j < 4; ++j) hr[tid + 256 * j] = hv4[j] + y[j];
}
__global__ void __launch_bounds__(256) s_moe_hid(const unsigned* __restrict__ gcnt, const int* __restrict__ EL, const float* __restrict__ EW, const bf16_t* __restrict__ XN2,
                                                 const float* __restrict__ wg, const float* __restrict__ wu, bf16_t* __restrict__ HID) {
    __shared__ float xn[D]; __shared__ int s_e, s_pos;
    const int tid = threadIdx.x;
    if (tid == 0) { int idx = blockIdx.x, e = 0; while (e < 31 && idx >= (int)gcnt[e]) { idx -= (int)gcnt[e]; ++e; } s_e = e; s_pos = idx; }
    __syncthreads();
    const int e = s_e, pos = s_pos;
    if (pos >= (int)gcnt[e]) return;
    const int ent = EL[(size_t)e * 16384 + pos], token = ent & 0xffff, slot = ent >> 16; const float cw = EW[(size_t)e * 16384 + pos];
    for (int c = tid; c < D; c += 256) xn[c] = bf2f(XN2[(size_t)token * D + c]);
    __syncthreads();
    const float* pg = wg + (size_t)e * D * FF + tid; const float* pu = wu + (size_t)e * D * FF + tid;
    float ag = 0.f, au = 0.f;
    for (int d = 0; d < D; ++d) { const float xv = xn[d]; ag += xv * pg[(size_t)d * FF]; au += xv * pu[(size_t)d * FF]; }
    HID[(size_t)token * 512 + slot * 256 + tid] = (bf16_t)f2bf(silu_f(ag) * au * cw);
}
__global__ void __launch_bounds__(256) s_moe_out(const int* __restrict__ TI, const bf16_t* __restrict__ HID, const float* __restrict__ wd, float* __restrict__ out) {
    __shared__ float hid[512];
    const int t = blockIdx.x, tid = threadIdx.x; const int ti = TI[t], ge_lo = ti & 0xff, ge_hi = (ti >> 8) & 0xff;
    hid[tid] = bf2f(HID[(size_t)t * 512 + tid]); hid[256 + tid] = bf2f(HID[(size_t)t * 512 + 256 + tid]);
    __syncthreads();
    float y[4] = {0.f, 0.f, 0.f, 0.f};
    const float* p0 = wd + (size_t)ge_lo * FF * D; const float* p1 = wd + (size_t)ge_hi * FF * D;
    for (int f = 0; f < FF; ++f) { const float a = hid[f], b = hid[256 + f];
#pragma unroll
        for (int j = 0; j < 4; ++j) y[j] += a * p0[(size_t)f * D + tid + 256 * j] + b * p1[(size_t)f * D + tid + 256 * j]; }
#pragma unroll
    for (int j = 0; j < 4; ++j) out[(size_t)t * D + tid + 256 * j] += y[j];
}
struct Args { const float* in[19]; float* out; unsigned char* ws; int ph_lo, ph_hi, li, pad; };
constexpr int N_PHASES = 10;

__global__ void __launch_bounds__(NWAVES * 64, 2) mk_fwd(Args args) {
    extern __shared__ __attribute__((aligned(16))) unsigned char lds[];
    Frame F;
    F.lds = (LAS unsigned char*)lds;
    F.MISC = (volatile LAS unsigned*)(F.lds + MISC_OFF);
    F.tid = threadIdx.x; F.lane = F.tid & 63; F.wave = __builtin_amdgcn_readfirstlane(F.tid >> 6);
    F.G = gridDim.x; { const int bx = blockIdx.x; F.vcu = (F.G % 8 == 0) ? (bx % 8) * (F.G / 8) + bx / 8 : bx; }
    unsigned char* ws = args.ws; F.ws = ws; F.out = args.out;
    F.ctl = (gu32*)(ws + WS_CTL);
    F.x = args.in[0]; F.meta = args.in[1]; F.norm1_w = args.in[2]; F.w_in = args.in[3]; F.q_norm_w = args.in[4]; F.k_norm_w = args.in[5]; F.sinks = args.in[6]; F.gate_up = args.in[7];
    F.gate_bias = args.in[8]; F.gla_norm_w = args.in[9]; F.w_ab = args.in[10]; F.w_gb = args.in[11]; F.w_out = args.in[12]; F.norm2_w = args.in[13]; F.r_g = args.in[14]; F.r_e = args.in[15];
    F.e_wg = args.in[16]; F.e_wu = args.in[17]; F.e_wd = args.in[18];
    for (int u = F.tid; u < (LDS_BYTES - LDSCTL_OFF) / 4; u += NWAVES * 64) ((LAS unsigned*)(F.lds + LDSCTL_OFF))[u] = 0u;
    __syncthreads();
    XcdBarrier bar = xcd_barrier_post((unsigned*)(F.ctl + CW_BAR) + args.li * XCD_BAR_WORDS, F.MISC + 8);
    const int lo = args.ph_lo, hi = args.ph_hi;
#ifdef DIAG_K
    const unsigned long long dg_t0 = __builtin_amdgcn_s_memrealtime(); unsigned long long dg_a = dg_t0, dg_b = dg_t0;
#define DG_STAMP(k) do { if ((k) == DIAG_K0 - 1) dg_a = __builtin_amdgcn_s_memrealtime(); if ((k) == DIAG_K) dg_b = __builtin_amdgcn_s_memrealtime(); } while (0)
#else
#define DG_STAMP(k) do {} while (0)
#endif
#define IN(k) (lo <= (k) && (k) < hi)
#define BOTH(k) (IN(k) && (k) + 1 < hi)
#define GRID_BAR() xcd_barrier(bar)
#define PH_END(k) do { if (BOTH(k)) GRID_BAR(); DG_STAMP(k); } while (0)

    if (IN(0)) { p0_prologue(F); p0_router_weights(F); PH_END(0); }

    if (IN(1)) {
        pg8::Gemm g{(const bf16_t*)(ws + WS_XN), (const bf16_t*)(ws + WS_WPT), MX, NP, D};
        pg8::ProjOrder So{F.G, (int)blockIdx.x};
        pg8::EpiProj E{(bf16_t*)(ws + WS_QA), (bf16_t*)(ws + WS_KA), (bf16_t*)(ws + WS_VA), (bf16_t*)(ws + WS_QG), (bf16_t*)(ws + WS_KG), (bf16_t*)(ws + WS_VG), (bf16_t*)(ws + WS_RG),
                       (bf16_t*)F.out, (bf16_t*)F.out + (size_t)M * 1024, (float*)(ws + WS_GK), F.q_norm_w, F.k_norm_w, F.gate_bias, (const float*)(ws + WS_ROPE)};
        pg8::gemm_phase<pg8::EpiProj, pg8::ProjOrder, true, true>(F.lds + RING_OFF, g, So, E);
        if (F.G == 256) { if (blockIdx.x >= 133) expert_weight_items(F, ((int)blockIdx.x - 133) * NWAVES + F.wave, 123 * NWAVES); }
        else expert_weight_items(F, (int)blockIdx.x * NWAVES + F.wave, F.G * NWAVES);
        PH_END(1);
    }

    if (IN(2)) { DG_MARK(F, 4); GlaIn gc, gn; int u = blockIdx.x; if (u < 1028) gla_a_load(F, u, gc); attn_phase(F); DG_MARK(F, 5); { for (; u < 1028; u += F.G) { const int un = u + F.G; if (un < 1028) gla_a_load(F, un, gn); gla_a_unit(F, u, gc); gc = gn; if (u < 256) DG_MARK(F, 6); } } DG_MARK(F, 7); PH_END(2); }
    if (IN(3)) { gla_scan_phase(F); PH_END(3); }
    if (IN(4)) { gla_c_phase(F); PH_END(4); }

    if (IN(5)) {
        pg8::Gemm g{(const bf16_t*)(ws + WS_ATT), (const bf16_t*)(ws + WS_WBT), 2 * M, 2048, 512};
        pg8::BranchOrder So{(int)blockIdx.x};
        pg8::EpiBranch E{(const bf16_t*)F.out, (const bf16_t*)F.out + (size_t)M * 1024, (bf16_t*)(ws + WS_T1), (bf16_t*)(ws + WS_MG)};
        pg8::gemm_phase<pg8::EpiBranch, pg8::BranchOrder, true, true>(F.lds + RING_OFF, g, So, E);
        PH_END(5);
    }

    if (IN(6)) {
        pg8::Gemm g{(const bf16_t*)(ws + WS_MG), (const bf16_t*)(ws + WS_WOT), M, D, D};
        pg8::StaticOrder So; So.init(M, D, F.G, (int)blockIdx.x);
        pg8::EpiOut E{F.x, F.out};
        pg8::gemm_phase<pg8::EpiOut, pg8::StaticOrder, false, true>(F.lds + RING_OFF, g, So, E);
        PH_END(6);
    }
    if (IN(7)) { router_phase(F); PH_END(7); }
    if (IN(8)) { moe1_phase(F); PH_END(8); }
    if (IN(9)) { moe2_phase(F); DG_STAMP(9); }
#ifdef DIAG_K
#ifdef DIAG_MA
    __syncthreads(); dg_a = F.MISC[16 + DIAG_MA]; dg_b = F.MISC[16 + DIAG_MB];
#endif
    if (blockIdx.x == 0) { const unsigned long long tend = __builtin_amdgcn_s_memrealtime() + 4ull * ((dg_b - dg_a) & 0xffffffffull); while (__builtin_amdgcn_s_memrealtime() < tend) __builtin_amdgcn_s_sleep(8); }
#endif
#undef IN
#undef BOTH
#undef GRID_BAR
}

extern "C" void kernel_launch(void* const* d_in, const int* in_sizes, int n_in, void* d_out, int out_size, void* d_ws, size_t ws_size, hipStream_t stream) {
    static int grid = 0;
    if (grid == 0) {
        if (n_in != 19 || out_size != M * D || ws_size < WS_END) { fprintf(stderr, "kernel_launch: unexpected shapes (n_in %d out %d ws %zu)\n", n_in, out_size, ws_size); grid = -1; return; }
        int dev = 0, cus = 0;
        if (hipGetDevice(&dev) != hipSuccess || hipDeviceGetAttribute(&cus, hipDeviceAttributeMultiprocessorCount, dev) != hipSuccess) { grid = -1; return; }
        if (hipFuncSetAttribute((const void*)mk_fwd, hipFuncAttributeMaxDynamicSharedMemorySize, LDS_BYTES) != hipSuccess) { fprintf(stderr, "kernel_launch: hipFuncSetAttribute failed\n"); grid = -1; return; }
        int per_cu = 0;
        if (hipOccupancyMaxActiveBlocksPerMultiprocessor(&per_cu, (const void*)mk_fwd, NWAVES * 64, LDS_BYTES) != hipSuccess || per_cu < 1) fprintf(stderr, "kernel_launch: occupancy query reports %d\n", per_cu);
        (void)hipGetLastError();
        grid = cus;
        if (grid != 256) fprintf(stderr, "kernel_launch: %d CUs (built for 256)\n", grid);
    }
    if (grid < 0) return;
    (void)hipMemsetAsync((char*)d_ws + WS_CTL, 0, CTL_ZERO_BYTES, stream);
    Args a{};
    for (int i = 0; i < 19; ++i) a.in[i] = (const float*)d_in[i];
    a.out = (float*)d_out; a.ws = (unsigned char*)d_ws;
    unsigned char* ws = (unsigned char*)d_ws;
    a.ph_lo = 0; a.ph_hi = 10; a.li = 0;
    hipLaunchKernelGGL(mk_fwd, dim3(grid), dim3(NWAVES * 64), LDS_BYTES, stream, a);
}
```

```cpp
#include <hip/hip_runtime.h>
#include <stdint.h>
#include <cstdio>

namespace cfg {
constexpr int D = 1024, NB = 8, S = 2048, NMETA = 16, BLK = 128, PADF = 112, T = S + BLK;
constexpr int M = NB * S;
constexpr int MX = M + 256;
constexpr int AH = 8, AKV = 2, HD = 64;
constexpr int GH = 4, GDK = 64, GDV = 128, GR = 16, CH = 64;
constexpr int NG = 4, EPG = 8, FF = 256, NE = NG * EPG;
constexpr int INTOT = 4368;
constexpr int OFF_QA = 0, OFF_KA = 512, OFF_VA = 640, OFF_QG = 768, OFF_KG = 1024, OFF_VG = 1280, OFF_RG = 1792, OFF_GD = 2304, OFF_GA = 2320, OFF_GG = 3344;
constexpr float EPS = 1e-6f;
constexpr int NP = 4608;
constexpr int NPOS = S + NMETA;
}
using namespace cfg;

typedef unsigned short bf16_t;
#define GAS __attribute__((address_space(1)))
#define LAS __attribute__((address_space(3)))
typedef unsigned v4u __attribute__((ext_vector_type(4)));
typedef unsigned v2u __attribute__((ext_vector_type(2)));
typedef float f32x4 __attribute__((ext_vector_type(4)));
typedef float f32x16 __attribute__((ext_vector_type(16)));
typedef short bf16x8 __attribute__((ext_vector_type(8)));
typedef short bf16x4 __attribute__((ext_vector_type(4)));
typedef GAS unsigned gu32;
#define RLX_AGENT __ATOMIC_RELAXED, __HIP_MEMORY_SCOPE_AGENT
#define LDS_WAIT() asm volatile("s_waitcnt lgkmcnt(0)" ::: "memory")
#define VM_WAIT() asm volatile("s_waitcnt vmcnt(0)" ::: "memory")

constexpr size_t MiB = 1u << 20;
constexpr size_t WS_CTL  = 0;
constexpr size_t CTL_ZERO_BYTES = 1 * MiB;
constexpr size_t WS_ROPE = 1 * MiB;
constexpr size_t WS_WBT  = 2 * MiB;
constexpr size_t WS_WOT  = 4 * MiB;
constexpr size_t WS_WGU  = 6 * MiB;
constexpr size_t WS_WD   = 38 * MiB;
constexpr size_t WS_R1   = 54 * MiB;
constexpr size_t WS_R2   = WS_R1 + (size_t)MX * 1024 * 2;
constexpr size_t WS_QA   = WS_R2 + (size_t)NP * 1024 * 2;
constexpr size_t WS_VG   = WS_QA + (size_t)M * 512 * 2;
constexpr size_t WS_KA   = WS_VG + (size_t)MX * 512 * 2;
constexpr size_t WS_VA   = WS_KA + (size_t)MX * 128 * 2;
constexpr size_t WS_QG   = WS_VA + (size_t)MX * 128 * 2;
constexpr size_t WS_KG   = WS_QG + (size_t)M * 256 * 2;
constexpr size_t WS_RG   = WS_KG + (size_t)MX * 256 * 2;
constexpr size_t WS_GK   = WS_RG + (size_t)M * 512 * 2;
constexpr size_t WS_A2   = WS_GK + (size_t)MX * 256 * 4;
constexpr size_t WS_KV   = WS_A2 + (size_t)M * 1024 * 2;
constexpr size_t WS_ST   = WS_KV + (size_t)1028 * 8192 * 2;
constexpr size_t WS_DEC  = WS_ST + (size_t)1024 * 8192 * 2;
constexpr size_t WS_END  = WS_DEC + (size_t)1028 * 64 * 4;
constexpr size_t WS_MG   = WS_QA;
constexpr size_t WS_OI   = WS_R1;
constexpr size_t WS_XN   = WS_R1;
constexpr size_t WS_WPT  = WS_R2;
constexpr size_t WS_QH   = WS_R2;
static_assert(WS_END <= 256 * MiB, "d_ws map");
static_assert(WS_QA + (size_t)M * 1024 * 2 <= WS_KA, "MERGED overlays QA|VG only");

__device__ __forceinline__ float bf2f(bf16_t v) { return __builtin_bit_cast(float, (unsigned)v << 16); }
__device__ __forceinline__ unsigned f2bf(float f) { unsigned u = __builtin_bit_cast(unsigned, f); return (u + 0x7fffu + ((u >> 16) & 1u)) >> 16; }
__device__ __forceinline__ unsigned pk2(float lo, float hi) { return f2bf(lo) | (f2bf(hi) << 16); }
__device__ __forceinline__ float fast_sigmoid(float z) { return __builtin_amdgcn_rcpf(1.f + __expf(-z)); }
__device__ __forceinline__ float log_sigmoid_f(float z) { return fminf(z, 0.f) - log1pf(expf(-fabsf(z))); }
__device__ __forceinline__ float sigmoid_f(float z) { return 1.f / (1.f + expf(-z)); }
__device__ __forceinline__ float silu_f(float z) { return z / (1.f + expf(-z)); }
namespace pg8 {
#define PG8_LAS __attribute__((address_space(3)))
typedef unsigned short bf16_t;
typedef short bf16x8 __attribute__((ext_vector_type(8)));
typedef float f32x4 __attribute__((ext_vector_type(4)));
typedef unsigned u32x4 __attribute__((ext_vector_type(4)));
constexpr int BM = 256, BK = 64, HALF = 128, HTB = HALF * BK * 2  , STAGE_BYTES = 8 * HTB, NXCD = 8, WGM = 8;

__host__ __device__ __forceinline__ int lds_byte(int r, int c) { const int st = (r >> 4) * 2 + (c >> 5), rr = r & 15, cc = c & 31, ob = rr * 64 + cc * 2; return st * 1024 + (ob ^ (((ob >> 9) & 1) << 5)); }
__host__ __device__ __forceinline__ void stage_rc(int b, int& R, int& C) { const int st = b / 1024, sb = b % 1024, swz = sb ^ (((sb >> 9) & 1) << 5); R = (st >> 1) * 16 + swz / 64; C = (st & 1) * 32 + (swz % 64) / 2; }
__host__ __device__ __forceinline__ int perm32(int rho) { const int n = rho >> 4, i = rho & 15; return 8 * (i >> 2) + 4 * n + (i & 3); }

struct Unit { int pm, pn, kb = 0, lb = 0, nv = 0, pn2 = -1; };
struct Gemm { const bf16_t* A; const bf16_t* Bt; int M, N, K, lda, ldb; };

struct StaticOrder {
    int nM, nN, nwg, G, c;
    __host__ __device__ void init(int M, int N, int G_, int c_) { nM = M / BM; nN = N / BM; nwg = nM * nN; G = G_; c = c_; }
    __host__ __device__ bool next(int i, Unit& u) const {
        const long L = (long)i * G + c; if (L >= nwg) return false;
        int wgid = (int)L; { const int q = nwg / NXCD, r = nwg % NXCD, xcd = wgid % NXCD, off = wgid / NXCD; wgid = (xcd < r ? xcd * (q + 1) : r * (q + 1) + (xcd - r) * q) + off; }
        const int nig = WGM * nN, gid = wgid / nig, fm = gid * WGM, gsz = (nM - fm) < WGM ? (nM - fm) : WGM;
        u.pm = fm + ((wgid % nig) % gsz); u.pn = (wgid % nig) / gsz; return true;
    }
    __device__ __forceinline__ void a_ready(const Unit&) const {}
    __device__ __forceinline__ void done(const Unit&) const {}
};

__device__ __forceinline__ unsigned cvt_pk_bf16(float lo, float hi) { unsigned r; asm volatile("v_cvt_pk_bf16_f32 %0, %1, %2" : "=v"(r) : "v"(lo), "v"(hi)); return r; }
struct ProjOrder {
    int G, c;
    __device__ bool next(int i, Unit& u) const {
        const int L = i * G + c; constexpr int nwg = 64 * 18;
        if (L >= nwg + 5) return false;
        if (L >= nwg) { const int k = L - nwg; u.pm = 64; u.pn = (k == 0) ? 2 : (k == 1) ? 4 : (k == 2) ? 5 : (k == 3) ? 6 : 9; return true; }
        const int q = nwg / NXCD, xcd = L % NXCD, off = L / NXCD; const int wgid = xcd * q + off;
        const int nig = WGM * 18, gid = wgid / nig, fm = gid * WGM;
        u.pm = fm + ((wgid % nig) % WGM); u.pn = (wgid % nig) / WGM; return true;
    }
    __device__ __forceinline__ void a_ready(const Unit&) const {}
    __device__ __forceinline__ void done(const Unit&) const {}
};
struct BranchOrder {
    int c;
    __device__ bool next(int i, Unit& u) const {
        if (i >= 2) return false;
        constexpr int nwg = 256; const int q = nwg / NXCD, xcd = c % NXCD, off = c / NXCD; const int wgid = xcd * q + off;
        const int nig = WGM * 4, gid = wgid / nig, fm = gid * WGM;
        u.pm = fm + ((wgid % nig) % WGM) + 64 * i; u.pn = (wgid % nig) / WGM + 4 * i; return true;
    }
    __device__ __forceinline__ void a_ready(const Unit&) const {}
    __device__ __forceinline__ void done(const Unit&) const {}
};

__device__ __forceinline__ v4u pack8(const f32x4& a, const f32x4& b) { v4u w; w.x = cvt_pk_bf16(a[0], a[1]); w.y = cvt_pk_bf16(a[2], a[3]); w.z = cvt_pk_bf16(b[0], b[1]); w.w = cvt_pk_bf16(b[2], b[3]); return w; }
__device__ __forceinline__ void unpack8(const v4u& w, f32x4& a, f32x4& b) {
    a[0] = __builtin_bit_cast(float, w.x << 16); a[1] = __builtin_bit_cast(float, w.x & 0xffff0000u); a[2] = __builtin_bit_cast(float, w.y << 16); a[3] = __builtin_bit_cast(float, w.y & 0xffff0000u);
    b[0] = __builtin_bit_cast(float, w.z << 16); b[1] = __builtin_bit_cast(float, w.z & 0xffff0000u); b[2] = __builtin_bit_cast(float, w.w << 16); b[3] = __builtin_bit_cast(float, w.w & 0xffff0000u);
}

struct EpiProj {
    static constexpr bool PERM = true, AFTER_DRAIN = false, ACC_CHAIN = false;
    __device__ __forceinline__ bool zero_after(const Unit&) const { return true; }
    bf16_t *QA, *KA, *VA, *QG, *KG, *VG, *RG, *SA, *SG; float* GK;
    const float *qnw, *knw, *gbias; const float* rope;
    __device__ __forceinline__ void operator()(const f32x4 (&acc)[2][2][4][2], const Unit& u, int wr, int wc, int fr, int fq) const {
        const int pn = u.pn; const int row0 = u.pm * BM + wr * 64 + fr;
        if (pn < 2 || (pn == 2 && wc < 2)) {
            const bool isq = pn < 2; const int head = isq ? pn * 4 + wc : wc; const float* nw = isq ? qnw : knw; bf16_t* dst = isq ? QA : KA; const int ldd = isq ? 512 : 128;
            const float osc = isq ? 0.125f : 1.0f;
            const f32x4 w1a = *(const f32x4*)(nw + 8 * fq), w1b = *(const f32x4*)(nw + 8 * fq + 4), w2a = *(const f32x4*)(nw + 32 + 8 * fq), w2b = *(const f32x4*)(nw + 32 + 8 * fq + 4);
            f32x4 csb[3][4];
#define EP_POS(g) ((row0 + ((g) >> 2) * HALF + ((g) & 3) * 16) < M ? ((row0 + ((g) >> 2) * HALF + ((g) & 3) * 16) & (S - 1)) + NMETA : (row0 + ((g) >> 2) * HALF + ((g) & 3) * 16) - M)
#define EP_LOAD(g) do { const float* rp_ = rope + ((size_t)EP_POS(g) * 32 + 8 * fq) * 2; _Pragma("unroll") for (int q_ = 0; q_ < 4; ++q_) csb[(g) % 3][q_] = *(const f32x4*)(rp_ + 4 * q_); } while (0)
            EP_LOAD(0); EP_LOAD(1);
#pragma unroll
            for (int g = 0; g < 8; ++g) {
                    if (g + 2 < 8) EP_LOAD(g + 2);
                    const int ai = g >> 2, m = g & 3;
                    const int row = row0 + ai * HALF + m * 16;
                    f32x4 x1a = acc[ai][0][m][0], x1b = acc[ai][0][m][1], x2a = acc[ai][1][m][0], x2b = acc[ai][1][m][1];
                    float ss = 0.f;
#pragma unroll
                    for (int j = 0; j < 4; ++j) ss += x1a[j] * x1a[j] + x1b[j] * x1b[j] + x2a[j] * x2a[j] + x2b[j] * x2b[j];
                    ss += __shfl_xor(ss, 16); ss += __shfl_xor(ss, 32);
                    const float r = rsqrtf(ss * (1.0f / 64.0f) + EPS) * osc;
                    const f32x4 cs0 = csb[g % 3][0], cs1 = csb[g % 3][1], cs2 = csb[g % 3][2], cs3 = csb[g % 3][3];
                    x1a = x1a * w1a * r; x1b = x1b * w1b * r; x2a = x2a * w2a * r; x2b = x2b * w2b * r;
                    f32x4 o1a, o1b, o2a, o2b;
                    o1a[0] = x1a[0] * cs0[0] - x2a[0] * cs0[1]; o2a[0] = x2a[0] * cs0[0] + x1a[0] * cs0[1];
                    o1a[1] = x1a[1] * cs0[2] - x2a[1] * cs0[3]; o2a[1] = x2a[1] * cs0[2] + x1a[1] * cs0[3];
                    o1a[2] = x1a[2] * cs1[0] - x2a[2] * cs1[1]; o2a[2] = x2a[2] * cs1[0] + x1a[2] * cs1[1];
                    o1a[3] = x1a[3] * cs1[2] - x2a[3] * cs1[3]; o2a[3] = x2a[3] * cs1[2] + x1a[3] * cs1[3];
                    o1b[0] = x1b[0] * cs2[0] - x2b[0] * cs2[1]; o2b[0] = x2b[0] * cs2[0] + x1b[0] * cs2[1];
                    o1b[1] = x1b[1] * cs2[2] - x2b[1] * cs2[3]; o2b[1] = x2b[1] * cs2[2] + x1b[1] * cs2[3];
                    o1b[2] = x1b[2] * cs3[0] - x2b[2] * cs3[1]; o2b[2] = x2b[2] * cs3[0] + x1b[2] * cs3[1];
                    o1b[3] = x1b[3] * cs3[2] - x2b[3] * cs3[3]; o2b[3] = x2b[3] * cs3[2] + x1b[3] * cs3[3];
                    bf16_t* rowp = dst + (size_t)row * ldd + head * 64 + 8 * fq;
                    *(v4u*)(rowp) = pack8(o1a, o1b); *(v4u*)(rowp + 32) = pack8(o2a, o2b);
                }
#undef EP_LOAD
#undef EP_POS
            return;
        }
        if (pn == 2) {
#pragma unroll
            for (int ai = 0; ai < 2; ++ai)
#pragma unroll
                for (int m = 0; m < 4; ++m) { const int row = row0 + ai * HALF + m * 16; bf16_t* rowp = VA + (size_t)row * 128 + (wc - 2) * 64 + 8 * fq;
#pragma unroll
                    for (int bj = 0; bj < 2; ++bj) *(v4u*)(rowp + 32 * bj) = pack8(acc[ai][bj][m][0], acc[ai][bj][m][1]); }
            return;
        }
        const int ct = wc * 32 + 8 * fq;
        if (pn == 9) {
#pragma unroll
            for (int bj = 0; bj < 2; ++bj) { const int col = ct + bj * HALF; const f32x4 b0 = *(const f32x4*)(gbias + col), b1 = *(const f32x4*)(gbias + col + 4);
#pragma unroll
                for (int ai = 0; ai < 2; ++ai)
#pragma unroll
                    for (int m = 0; m < 4; ++m) { const int row = row0 + ai * HALF + m * 16; f32x4 z0 = acc[ai][bj][m][0] + b0, z1 = acc[ai][bj][m][1] + b1;
#pragma unroll
                        for (int j = 0; j < 4; ++j) { z0[j] = (fminf(z0[j], 0.f) - __logf(1.f + __expf(-fabsf(z0[j])))) * 0.0625f; z1[j] = (fminf(z1[j], 0.f) - __logf(1.f + __expf(-fabsf(z1[j])))) * 0.0625f; }
                        float* rowp = GK + (size_t)row * 256 + col; *(f32x4*)rowp = z0; *(f32x4*)(rowp + 4) = z1; } }
            return;
        }
        bf16_t* dst; int ldd, cbase, act; float sc = 1.f;
        if (pn == 3) { dst = QG; ldd = 256; cbase = 0; act = 0; sc = 0.125f; }
        else if (pn == 4) { dst = KG; ldd = 256; cbase = 0; act = 0; }
        else if (pn < 7) { dst = VG; ldd = 512; cbase = (pn - 5) * 256; act = 0; }
        else if (pn < 9) { dst = RG; ldd = 512; cbase = (pn - 7) * 256; act = 1; }
        else {
            const int cg = (pn - 10) * 128 + ct;
#pragma unroll
            for (int ai = 0; ai < 2; ++ai)
#pragma unroll
                for (int m = 0; m < 4; ++m) { const size_t o = (size_t)(row0 + ai * HALF + m * 16) * 1024 + cg; f32x4 r0, r1, s0, s1;
#pragma unroll
                    for (int j = 0; j < 4; ++j) { const float ea0 = __expf(-acc[ai][0][m][0][j]), ea1 = __expf(-acc[ai][0][m][1][j]), eg0 = __expf(-acc[ai][1][m][0][j]), eg1 = __expf(-acc[ai][1][m][1][j]);
                        s0[j] = __builtin_amdgcn_rcpf(1.f + eg0); s1[j] = __builtin_amdgcn_rcpf(1.f + eg1);
                        r0[j] = (1.f + eg0) * __builtin_amdgcn_rcpf(1.f + ea0); r1[j] = (1.f + eg1) * __builtin_amdgcn_rcpf(1.f + ea1); }
                    *(v4u*)(SA + o) = pack8(r0, r1); *(v4u*)(SG + o) = pack8(s0, s1); }
            return;
        }
#pragma unroll
        for (int ai = 0; ai < 2; ++ai)
#pragma unroll
            for (int m = 0; m < 4; ++m) { const int row = row0 + ai * HALF + m * 16; bf16_t* rowp = dst + (size_t)row * ldd + cbase + ct;
#pragma unroll
                for (int bj = 0; bj < 2; ++bj) { f32x4 v0 = acc[ai][bj][m][0] * sc, v1 = acc[ai][bj][m][1] * sc;
                    if (act != 0) {
#pragma unroll
                        for (int j = 0; j < 4; ++j) { const float s0 = fast_sigmoid(v0[j]), s1 = fast_sigmoid(v1[j]); v0[j] = (act == 1) ? v0[j] * s0 : s0; v1[j] = (act == 1) ? v1[j] * s1 : s1; } }
                    *(v4u*)(rowp + bj * HALF) = pack8(v0, v1); } }
    }
};

struct MergeOrder {
    int c;
    __device__ bool next(int i, Unit& u) const {
        if (i >= 2) return false;
        constexpr int nwg = 256; const int q = nwg / NXCD, xcd = c % NXCD, off = c / NXCD; const int wgid = xcd * q + off;
        const int nig = WGM * 4, gid = wgid / nig, fm = gid * WGM;
        u.pm = fm + ((wgid % nig) % WGM); u.pn = (wgid % nig) / WGM; u.kb = 512 * i; return true;
    }
    __device__ __forceinline__ void a_ready(const Unit&) const {}
    __device__ __forceinline__ void done(const Unit&) const {}
};
struct EpiMerge {
    static constexpr bool PERM = true, AFTER_DRAIN = false, ACC_CHAIN = true;
    const bf16_t *RA, *SG; bf16_t* MG;
    __device__ __forceinline__ bool zero_after(const Unit& u) const { return u.kb != 0; }
    __device__ __forceinline__ void operator()(f32x4 (&acc)[2][2][4][2], const Unit& u, int wr, int wc, int fr, int fq) const {
        const int row0 = u.pm * BM + wr * 64 + fr, col0 = u.pn * BM + wc * 32 + 8 * fq;
        const bool first = u.kb == 0;
        const bf16_t* Fp = first ? RA : SG;
        v4u gv[3][2];
#define EM_LOAD(g) do { const size_t off_ = (size_t)(row0 + ((g) >> 2) * HALF + ((g) & 3) * 16) * 1024 + col0; _Pragma("unroll") for (int bj_ = 0; bj_ < 2; ++bj_) gv[(g) % 3][bj_] = *(const v4u*)(Fp + off_ + bj_ * HALF); } while (0)
        EM_LOAD(0); EM_LOAD(1);
#pragma unroll
        for (int g = 0; g < 8; ++g) {
            if (g + 2 < 8) EM_LOAD(g + 2);
            const int ai = g >> 2, m = g & 3; const size_t off = (size_t)(row0 + ai * HALF + m * 16) * 1024 + col0;
#pragma unroll
            for (int bj = 0; bj < 2; ++bj) { f32x4 g0, g1; unpack8(gv[g % 3][bj], g0, g1);
                acc[ai][bj][m][0] = acc[ai][bj][m][0] * g0; acc[ai][bj][m][1] = acc[ai][bj][m][1] * g1;
                if (!first) *(v4u*)(MG + off + bj * HALF) = pack8(acc[ai][bj][m][0], acc[ai][bj][m][1]); }
        }
#undef EM_LOAD
    }
};

struct EpiOut {
    static constexpr bool PERM = false, AFTER_DRAIN = false, ACC_CHAIN = false;
    __device__ __forceinline__ bool zero_after(const Unit&) const { return true; }
    const float* X; float* O;
    __device__ __forceinline__ void operator()(const f32x4 (&acc)[2][2][4][2], const Unit& u, int wr, int wc, int fr, int fq) const {
        const int row0 = u.pm * BM + wr * 64 + fr, col0 = u.pn * BM + wc * 32 + 4 * fq;
        f32x4 xb[3][4];
#define EO_LOAD(g) do { const size_t off_ = (size_t)(row0 + ((g) >> 2) * HALF + ((g) & 3) * 16) * 1024 + col0; _Pragma("unroll") for (int q_ = 0; q_ < 4; ++q_) xb[(g) % 3][q_] = *(const f32x4*)(X + off_ + (q_ >> 1) * HALF + (q_ & 1) * 16); } while (0)
        EO_LOAD(0); EO_LOAD(1);
#pragma unroll
        for (int g = 0; g < 8; ++g) {
            if (g + 2 < 8) EO_LOAD(g + 2);
            const int ai = g >> 2, m = g & 3; const size_t off = (size_t)(row0 + ai * HALF + m * 16) * 1024 + col0;
#pragma unroll
            for (int q = 0; q < 4; ++q) *(f32x4*)(O + off + (q >> 1) * HALF + (q & 1) * 16) = xb[g % 3][q] + acc[ai][q >> 1][m][q & 1];
        }
#undef EO_LOAD
    }
};

struct MoeOrder {
    int G, c; const PG8_LAS int* pre; const unsigned* gcnt; int cstr; const int* EL;
    __device__ bool next(int i, Unit& u) const {
        const int L = i * G + c; if (L >= pre[32]) return false;
        int e = 0; while (e < 31 && L >= pre[e + 1]) ++e;
        const int q = L - pre[e], mt = q >> 1, tn = q & 1, cnt = (int)gcnt[cstr * e];
        u.pm = 0; u.pn = e * 2 + tn; u.kb = 0; u.lb = e * 16384 + mt * 256; u.nv = (cnt - mt * 256 < 256) ? (cnt - mt * 256) : 256; return true;
    }
    __device__ __forceinline__ unsigned row_off(const Unit& u, int r) const { return (unsigned)(EL[u.lb + ((r < u.nv) ? r : 0)] & 0xffff) * 2048u; }
    __device__ __forceinline__ void a_ready(const Unit&) const {}
    __device__ __forceinline__ void done(const Unit&) const {}
};
struct EpiMoe1g {
    static constexpr bool PERM = true, AFTER_DRAIN = false, ACC_CHAIN = false;
    __device__ __forceinline__ bool zero_after(const Unit&) const { return true; }
    const int* EL; const float* EW; bf16_t* HID;
    __device__ __forceinline__ void operator()(const f32x4 (&acc)[2][2][4][2], const Unit& u, int wr, int wc, int fr, int fq) const {
        const int tn = u.pn & 1;
        int ent[2][4]; float cw[2][4];
#pragma unroll
        for (int ai = 0; ai < 2; ++ai)
#pragma unroll
            for (int m = 0; m < 4; ++m) { const int r = ai * HALF + wr * 64 + m * 16 + fr, idx = u.lb + ((r < u.nv) ? r : 0); ent[ai][m] = EL[idx]; cw[ai][m] = EW[idx]; }
#pragma unroll
        for (int ai = 0; ai < 2; ++ai)
#pragma unroll
            for (int m = 0; m < 4; ++m) { const int r = ai * HALF + wr * 64 + m * 16 + fr; if (r >= u.nv) continue;
                const float w = cw[ai][m]; f32x4 h0, h1;
#pragma unroll
                for (int j = 0; j < 4; ++j) { const float g0 = acc[ai][0][m][0][j], g1 = acc[ai][0][m][1][j]; h0[j] = g0 * fast_sigmoid(g0) * acc[ai][1][m][0][j] * w; h1[j] = g1 * fast_sigmoid(g1) * acc[ai][1][m][1][j] * w; }
                *(v4u*)(HID + (size_t)(ent[ai][m] & 0xffff) * 512 + (ent[ai][m] >> 16) * 256 + tn * 128 + wc * 32 + 8 * fq) = pack8(h0, h1); }
    }
};

struct Moe2Order {
    int G, c; const PG8_LAS int* pre; const unsigned* pcnt; int cstr; const int* PL;
    __device__ bool next(int i, Unit& u) const {
        const int L = i * G + c; if (L >= pre[112]) return false;
        int p = 0; while (p < 111 && L >= pre[p + 1]) ++p;
        const int q = L - pre[p], mt = q >> 2, tn = q & 3, cnt = (int)pcnt[cstr * p];
        const int g = p / 28; int pi = p - g * 28, elo = 0; while (pi >= 7 - elo) { pi -= 7 - elo; ++elo; } const int ehi = elo + 1 + pi;
        u.pm = tn; u.pn = (8 * g + elo) * 4 + tn; u.pn2 = (8 * g + ehi) * 4 + tn; u.kb = 0; u.lb = p * 16384 + mt * 256; u.nv = (cnt - mt * 256 < 256) ? (cnt - mt * 256) : 256; return true;
    }
    __device__ __forceinline__ unsigned row_off(const Unit& u, int r) const { return (unsigned)PL[u.lb + ((r < u.nv) ? r : 0)] * 1024u; }
    __device__ __forceinline__ void a_ready(const Unit&) const {}
    __device__ __forceinline__ void done(const Unit&) const {}
};
struct EpiMoe2g {
    static constexpr bool PERM = true, AFTER_DRAIN = false, ACC_CHAIN = false;
    __device__ __forceinline__ bool zero_after(const Unit&) const { return true; }
    const int* PL; float* O;
    __device__ __forceinline__ void operator()(const f32x4 (&acc)[2][2][4][2], const Unit& u, int wr, int wc, int fr, int fq) const {
        const unsigned cofs = (unsigned)(u.pm * 256 + wc * 32 + 8 * fq) * 4u;
        unsigned tof[2][4];
#pragma unroll
        for (int ai = 0; ai < 2; ++ai)
#pragma unroll
            for (int m = 0; m < 4; ++m) { const int r = ai * HALF + wr * 64 + m * 16 + fr; tof[ai][m] = (unsigned)PL[u.lb + ((r < u.nv) ? r : 0)] * 4096u + cofs; }
        char* Ob = (char*)O;
        f32x4 xb[2][4];
#define E2_LOAD(g) do { const char* op_ = Ob + tof[(g) >> 2][(g) & 3]; xb[(g) & 1][0] = *(const f32x4*)(op_); xb[(g) & 1][1] = *(const f32x4*)(op_ + 16); xb[(g) & 1][2] = *(const f32x4*)(op_ + 512); xb[(g) & 1][3] = *(const f32x4*)(op_ + 528); } while (0)
        E2_LOAD(0);
#pragma unroll
        for (int g = 0; g < 8; ++g) {
            if (g + 1 < 8) E2_LOAD(g + 1);
            const int ai = g >> 2, m = g & 3, r = ai * HALF + wr * 64 + m * 16 + fr;
            if (r < u.nv) { char* op = Ob + tof[ai][m];
                *(f32x4*)(op) = xb[g & 1][0] + acc[ai][0][m][0]; *(f32x4*)(op + 16) = xb[g & 1][1] + acc[ai][0][m][1];
                *(f32x4*)(op + 512) = xb[g & 1][2] + acc[ai][1][m][0]; *(f32x4*)(op + 528) = xb[g & 1][3] + acc[ai][1][m][1]; }
        }
#undef E2_LOAD
    }
};
template <class Epi, class Sched, bool ALIGN_EPI = false, bool SP2 = false, bool GATHER = false>
__device__ __forceinline__ void gemm_phase(PG8_LAS unsigned char* lds, const Gemm g, const Sched& S, const Epi& E) {
    const int tid = threadIdx.x, wid = __builtin_amdgcn_readfirstlane(tid >> 6), lane = tid & 63, wr = wid >> 2, wc = wid & 3, fr = lane & 15, fq = lane >> 4;
    const int K = g.K, nt = K / BK, LDA = g.lda, LDB = g.ldb;
    unsigned voffA[2], voffB[2];
#pragma unroll
    for (int i = 0; i < 2; ++i) { int R, C; stage_rc(tid * 16 + i * 8192, R, C); const int Rb = Epi::PERM ? ((R & ~31) + perm32(R & 31)) : R;
        voffA[i] = (unsigned)(R * LDA + C) * 2u; voffB[i] = (unsigned)(Rb * LDB + C) * 2u; }
    static_assert(!GATHER || SP2, "GATHER needs the SP2 loop");
    unsigned cvo[2][2], nvo[2][2];
    PG8_LAS unsigned* nslot = (PG8_LAS unsigned*)(lds + 133120 + tid * 16);
#define PG8_ROWOFFS(dst, un) do { _Pragma("unroll") for (int h_ = 0; h_ < 2; ++h_) _Pragma("unroll") for (int i_ = 0; i_ < 2; ++i_) { int R_, C_; stage_rc(tid * 16 + i_ * 8192, R_, C_); dst[h_][i_] = S.row_off(un, h_ * HALF + R_) + (unsigned)(C_ * 2); } } while (0)
    const size_t kstep = (size_t)(BK * 2);
    const size_t hstepA = (size_t)HALF * LDA * 2, hstepB = (size_t)HALF * LDB * 2;
    const size_t tstepA = 2 * hstepA, tstepB = 2 * hstepB;
    const unsigned ldsw = (unsigned)wid * 1024u;
    const int aoff = lds_byte(wr * 64 + fr, fq * 8), boff = lds_byte(wc * 32 + fr, fq * 8);
#define PG8_SA(b, h) (((b) * 2 + (h)) * HTB)
#define PG8_SB(b, h) ((4 + (b) * 2 + (h)) * HTB)
#define PG8_STAGE(bufoff, gbase, voff) do { _Pragma("unroll") for (int _i = 0; _i < 2; ++_i) \
        __builtin_amdgcn_global_load_lds((const unsigned*)((const char*)(gbase) + (voff)[_i]), (PG8_LAS unsigned*)(lds + (bufoff) + ldsw + _i * 8192), 16, 0, 0); } while (0)
#define PG8_STAGEA(bufoff, gbase, half, which) do { if constexpr (GATHER) { unsigned vo_[2]; _Pragma("unroll") for (int i_ = 0; i_ < 2; ++i_) vo_[i_] = ((which) && use_next) ? nvo[half][i_] : cvo[half][i_]; PG8_STAGE(bufoff, gbase, vo_); } \
        else { PG8_STAGE(bufoff, (gbase) + ((half) ? hstepA : 0), voffA); } } while (0)
#define PG8_LDA(dst, b, h) do { _Pragma("unroll") for (int m = 0; m < 4; ++m) _Pragma("unroll") for (int k = 0; k < 2; ++k) dst[m][k] = *(const PG8_LAS bf16x8*)(lds + PG8_SA(b, h) + aoff + m * 2048 + k * 1024); } while (0)
#define PG8_LDB(dst, b, h) do { _Pragma("unroll") for (int n = 0; n < 2; ++n) _Pragma("unroll") for (int k = 0; k < 2; ++k) dst[n][k] = *(const PG8_LAS bf16x8*)(lds + PG8_SB(b, h) + boff + n * 2048 + k * 1024); } while (0)
#define PG8_MMA(ai, bj, At, Bt) do { __builtin_amdgcn_s_setprio(1); _Pragma("unroll") for (int m = 0; m < 4; ++m) _Pragma("unroll") for (int n = 0; n < 2; ++n) _Pragma("unroll") for (int k = 0; k < 2; ++k) \
        acc[ai][bj][m][n] = __builtin_amdgcn_mfma_f32_16x16x32_bf16(Bt[n][k], At[m][k], acc[ai][bj][m][n], 0, 0, 0); __builtin_amdgcn_s_setprio(0); } while (0)
#define PG8_WAIT_V(n) asm volatile("s_waitcnt vmcnt(" #n ")" ::: "memory")
#define PG8_WAIT_L(n) asm volatile("s_waitcnt lgkmcnt(" #n ")" ::: "memory")
#define PG8_BAR __builtin_amdgcn_s_barrier()
#define PG8_SCHED __builtin_amdgcn_sched_barrier(0)
    Unit cur, nxt; int ui = 0;
    if (!S.next(0, cur)) return;
    f32x4 acc[2][2][4][2];
#pragma unroll
    for (int a = 0; a < 2; ++a)
#pragma unroll
        for (int b = 0; b < 2; ++b)
#pragma unroll
            for (int m = 0; m < 4; ++m)
#pragma unroll
                for (int n = 0; n < 2; ++n) acc[a][b][m][n] = (f32x4){0.f, 0.f, 0.f, 0.f};
    bf16x8 At[4][2], B0[2][2], B1[2][2];
    const char* cA = (const char*)g.A + (GATHER ? (size_t)0 : (size_t)cur.pm * tstepA) + (size_t)cur.kb * 2; const char* cB = (const char*)g.Bt + (size_t)cur.pn * tstepB + (size_t)cur.kb * 2;
    constexpr bool use_next = false;
    if constexpr (GATHER) { PG8_ROWOFFS(cvo, cur);
#pragma unroll
        for (int h = 0; h < 2; ++h)
#pragma unroll
            for (int i = 0; i < 2; ++i) nvo[h][i] = cvo[h][i]; }
    S.a_ready(cur);
    if constexpr (SP2) {
        PG8_STAGE(PG8_SB(0, 0), cB, voffB); PG8_STAGE(PG8_SB(0, 1), cB + hstepB, voffB); PG8_STAGEA(PG8_SA(0, 0), cA, 0, 0); PG8_STAGEA(PG8_SA(0, 1), cA, 1, 0);
        if (wr == 1) PG8_BAR;
        PG8_WAIT_V(2); PG8_BAR;
        PG8_STAGE(PG8_SB(1, 0), cB + kstep, voffB); PG8_STAGEA(PG8_SA(1, 0), cA + kstep, 0, 0); PG8_STAGE(PG8_SB(1, 1), cB + hstepB + kstep, voffB);
        PG8_WAIT_V(6); PG8_BAR;
    } else {
        PG8_STAGE(PG8_SB(0, 0), cB, voffB); PG8_STAGE(PG8_SA(0, 0), cA, voffA); PG8_STAGE(PG8_SB(0, 1), cB + hstepB, voffB); PG8_STAGE(PG8_SA(0, 1), cA + hstepA, voffA);
        if (wr == 1) PG8_BAR;
        PG8_WAIT_V(4); PG8_BAR;
        PG8_STAGE(PG8_SB(1, 0), cB + kstep, voffB); PG8_STAGE(PG8_SA(1, 0), cA + kstep, voffA); PG8_STAGE(PG8_SB(1, 1), cB + hstepB + kstep, voffB);
        PG8_WAIT_V(6); PG8_BAR;
    }
    for (;;) {
        const bool has_next = S.next(ui + 1, nxt);
        if constexpr (GATHER) { if (has_next) PG8_ROWOFFS(nvo, nxt); else { nvo[0][0] = cvo[0][0]; nvo[0][1] = cvo[0][1]; nvo[1][0] = cvo[1][0]; nvo[1][1] = cvo[1][1]; }
            *(PG8_LAS u32x4*)nslot = (u32x4){nvo[0][0], nvo[0][1], nvo[1][0], nvo[1][1]}; }
        const int bdlt = (cur.pn2 >= 0) ? (cur.pn2 - cur.pn) * (int)tstepB - (nt / 2) * (int)kstep : 0;
        const char* nA = has_next ? (const char*)g.A + (GATHER ? (size_t)0 : (size_t)nxt.pm * tstepA) + (size_t)nxt.kb * 2 : cA; const char* nB = has_next ? (const char*)g.Bt + (size_t)nxt.pn * tstepB + (size_t)nxt.kb * 2 : cB;
        for (int t = 0; t < nt; t += 2) {
            const bool last = (t == nt - 2);
            const char* a1 = cA + (size_t)(t + 1) * kstep;
            const char* a2 = last ? nA : cA + (size_t)(t + 2) * kstep; const char* b2 = last ? nB : cB + (size_t)(t + 2) * kstep + ((t + 2 >= nt / 2) ? bdlt : 0);
            const char* a3 = a2 + kstep; const char* b3 = b2 + kstep;
            if (last && has_next) S.a_ready(nxt);
            const bool use_next = last;
            if constexpr (GATHER) { if (last) { const u32x4 nv_ = *(const PG8_LAS u32x4*)nslot; nvo[0][0] = nv_.x; nvo[0][1] = nv_.y; nvo[1][0] = nv_.z; nvo[1][1] = nv_.w; } }
            if constexpr (SP2) {
            PG8_LDB(B0, 0, 0); PG8_LDB(B1, 0, 1); PG8_SCHED; PG8_LDA(At, 0, 0); PG8_STAGEA(PG8_SA(1, 1), a1, 1, 0);
            PG8_WAIT_V(8); PG8_WAIT_L(0); PG8_BAR; PG8_MMA(0, 0, At, B0); PG8_MMA(0, 1, At, B1); PG8_BAR; PG8_SCHED;
            PG8_LDA(At, 0, 1); PG8_STAGE(PG8_SB(0, 0), b2, voffB); PG8_STAGE(PG8_SB(0, 1), b2 + hstepB, voffB); PG8_STAGEA(PG8_SA(0, 0), a2, 0, 1);
            PG8_WAIT_V(8); PG8_WAIT_L(0); PG8_BAR; PG8_MMA(1, 0, At, B0); PG8_MMA(1, 1, At, B1); PG8_BAR; PG8_SCHED;
            PG8_LDB(B0, 1, 0); PG8_LDB(B1, 1, 1); PG8_SCHED; PG8_LDA(At, 1, 0); PG8_STAGEA(PG8_SA(0, 1), a2, 1, 1);
            PG8_WAIT_V(8); PG8_WAIT_L(0); PG8_BAR; PG8_MMA(0, 0, At, B0); PG8_MMA(0, 1, At, B1); PG8_BAR; PG8_SCHED;
            PG8_LDA(At, 1, 1); PG8_STAGE(PG8_SB(1, 0), b3, voffB); PG8_STAGE(PG8_SB(1, 1), b3 + hstepB, voffB); PG8_STAGEA(PG8_SA(1, 0), a3, 0, 1);
            PG8_WAIT_V(8); PG8_WAIT_L(0); PG8_BAR; PG8_MMA(1, 0, At, B0); PG8_MMA(1, 1, At, B1); PG8_BAR; PG8_SCHED;
            } else {
            PG8_LDB(B0, 0, 0); PG8_SCHED; PG8_LDA(At, 0, 0); PG8_STAGE(PG8_SA(1, 1), a1 + hstepA, voffA);
            PG8_WAIT_L(8); PG8_BAR; PG8_WAIT_L(0); PG8_MMA(0, 0, At, B0); PG8_BAR; PG8_SCHED;
            PG8_LDB(B1, 0, 1); PG8_STAGE(PG8_SB(0, 0), b2, voffB);
            PG8_BAR; PG8_WAIT_L(0); PG8_MMA(0, 1, At, B1); PG8_BAR;
            PG8_LDA(At, 0, 1); PG8_STAGE(PG8_SA(0, 0), a2, voffA);
            PG8_BAR; PG8_WAIT_L(0); PG8_MMA(1, 0, At, B0); PG8_BAR; PG8_SCHED;
            PG8_STAGE(PG8_SB(0, 1), b2 + hstepB, voffB);
            PG8_WAIT_V(6); PG8_BAR; PG8_MMA(1, 1, At, B1); PG8_BAR;
            PG8_LDB(B0, 1, 0); PG8_SCHED; PG8_LDA(At, 1, 0); PG8_STAGE(PG8_SA(0, 1), a2 + hstepA, voffA);
            PG8_WAIT_L(8); PG8_BAR; PG8_WAIT_L(0); PG8_MMA(0, 0, At, B0); PG8_BAR; PG8_SCHED;
            PG8_LDB(B1, 1, 1); PG8_STAGE(PG8_SB(1, 0), b3, voffB);
            PG8_BAR; PG8_WAIT_L(0); PG8_MMA(0, 1, At, B1); PG8_BAR;
            PG8_LDA(At, 1, 1); PG8_STAGE(PG8_SA(1, 0), a3, voffA);
            PG8_BAR; PG8_WAIT_L(0); PG8_MMA(1, 0, At, B0); PG8_BAR; PG8_SCHED;
            PG8_STAGE(PG8_SB(1, 1), b3 + hstepB, voffB);
            PG8_WAIT_V(6); PG8_BAR; PG8_MMA(1, 1, At, B1); PG8_BAR;
            }
        }
        if constexpr (ALIGN_EPI) { if (wr == 0) PG8_BAR; }
        if constexpr (!Epi::AFTER_DRAIN) { E(acc, cur, wr, wc, fr, fq); S.done(cur); }
        if (!has_next) break;
        if constexpr (Epi::ACC_CHAIN) {
            const float z_ = E.zero_after(cur) ? 0.f : 1.f;
#pragma unroll
            for (int a = 0; a < 2; ++a)
#pragma unroll
                for (int b = 0; b < 2; ++b)
#pragma unroll
                    for (int m = 0; m < 4; ++m)
#pragma unroll
                        for (int n = 0; n < 2; ++n) acc[a][b][m][n] = acc[a][b][m][n] * z_;
        } else {
#pragma unroll
        for (int a = 0; a < 2; ++a)
#pragma unroll
            for (int b = 0; b < 2; ++b)
#pragma unroll
                for (int m = 0; m < 4; ++m)
#pragma unroll
                    for (int n = 0; n < 2; ++n) acc[a][b][m][n] = (f32x4){0.f, 0.f, 0.f, 0.f};
        }
        cur = nxt; cA = nA; cB = nB; ++ui;
        if constexpr (GATHER) { const u32x4 nv_ = *(const PG8_LAS u32x4*)nslot; cvo[0][0] = nv_.x; cvo[0][1] = nv_.y; cvo[1][0] = nv_.z; cvo[1][1] = nv_.w; }
        if constexpr (ALIGN_EPI) { if (wr == 1) PG8_BAR; }
    }
    PG8_WAIT_V(0);
    if constexpr (!ALIGN_EPI) { if (wr == 0) PG8_BAR; }
    PG8_BAR;
    if constexpr (Epi::AFTER_DRAIN) { E.fused(acc, cur, wr, wc, fr, fq, lds, wid, lane); S.done(cur); }
#undef PG8_SA
#undef PG8_SB
#undef PG8_STAGE
#undef PG8_STAGEA
#undef PG8_ROWOFFS
#undef PG8_LDA
#undef PG8_LDB
#undef PG8_MMA
#undef PG8_WAIT_V
#undef PG8_WAIT_L
#undef PG8_BAR
#undef PG8_SCHED
}
}
#define XB_TMO      128
#define XB_XCNT(j)  (256  + 64 * (j))
#define XB_XSUB(j)  (1280 + 64 * (j))
#define XB_XGEN(j)  (2304 + 64 * (j))
#define XB_TOP      3328
#define XB_TOPGEN   3392
#define XCD_BAR_WORDS 3456
#define XB_SPIN_CAP (1u << 18)

__device__ __forceinline__ unsigned xb_ld(unsigned* p)              { return __hip_atomic_load(p, __ATOMIC_RELAXED, __HIP_MEMORY_SCOPE_AGENT); }
__device__ __forceinline__ unsigned xb_add(unsigned* p, unsigned v) { return __hip_atomic_fetch_add(p, v, __ATOMIC_RELAXED, __HIP_MEMORY_SCOPE_AGENT); }
__device__ __forceinline__ unsigned xb_xcc_id() { return (unsigned)__builtin_amdgcn_s_getreg((3 << 11) | 20) & 0xFu; }
#define XB_SPIN(cond, bar) do { unsigned _sp = 0; while (cond) { __builtin_amdgcn_s_sleep(1); \
    if ((++_sp & 255u) == 0u) { if (xb_ld(&(bar)[XB_TMO])) break; if (_sp > XB_SPIN_CAP) { atomicAdd(&(bar)[XB_TMO], 1u); break; } } } } while (0)

struct XcdBarrier {
    unsigned* bar; unsigned x;
    volatile LAS unsigned* st;
};

__device__ __forceinline__ XcdBarrier xcd_barrier_post(unsigned* bar, volatile LAS unsigned* st) {
    XcdBarrier b; b.bar = bar; b.x = xb_xcc_id(); b.st = st;
    if (threadIdx.x == 0) (void)xb_add(&bar[XB_XCNT(b.x)], 1u);
    return b;
}
__device__ __forceinline__ void xcd_barrier_complete(unsigned* bar, unsigned x, unsigned& nloc, unsigned& nx) {
    const unsigned G = gridDim.x * gridDim.y * gridDim.z;
    unsigned sum, cnt, mine, sp = 0u;
    for (;;) {
        sum = 0u; cnt = 0u; mine = 0u;
#pragma unroll
        for (unsigned j = 0; j < 16; ++j) { const unsigned c = xb_ld(&bar[XB_XCNT(j)]); sum += c; cnt += (c > 0u) ? 1u : 0u; mine = (j == x) ? c : mine; }
        if (sum == G) break;
        __builtin_amdgcn_s_sleep(1);
        if ((++sp & 255u) == 0u) { if (xb_ld(&bar[XB_TMO])) break; if (sp > XB_SPIN_CAP) { atomicAdd(&bar[XB_TMO], 1u); break; } }
    }
    nloc = mine > 0u ? mine : 1u; nx = cnt > 0u ? cnt : 1u;
}

__device__ __forceinline__ void xcd_barrier(const XcdBarrier& b) {
    asm volatile("s_waitcnt vmcnt(0)" ::: "memory");
    __syncthreads();
    if (threadIdx.x == 0) {
        unsigned* bar = b.bar;
        __builtin_amdgcn_s_waitcnt(0);
        unsigned nloc = b.st[0], nx = b.st[1];
        if (nloc == 0u) { xcd_barrier_complete(bar, b.x, nloc, nx); b.st[0] = nloc; b.st[1] = nx; }
        const unsigned old = xb_add(&bar[XB_XSUB(b.x)], 1u);
        const unsigned gen = old / nloc;
        if (old + 1u == (gen + 1u) * nloc) {
            __builtin_amdgcn_fence(__ATOMIC_RELEASE, "agent");
            asm volatile("s_waitcnt vmcnt(0)" ::: "memory");
            const unsigned og = xb_add(&bar[XB_TOP], 1u);
            const unsigned tg = og / nx;
            if (og + 1u == (tg + 1u) * nx) xb_add(&bar[XB_TOPGEN], 1u);
            else XB_SPIN(xb_ld(&bar[XB_TOPGEN]) == tg, bar);
            __builtin_amdgcn_fence(__ATOMIC_ACQUIRE, "agent");
            xb_add(&bar[XB_XGEN(b.x)], 1u);
            asm volatile("s_waitcnt vmcnt(0)" ::: "memory");
        } else {
            XB_SPIN(xb_ld(&bar[XB_XGEN(b.x)]) == gen, bar);
            __builtin_amdgcn_fence(__ATOMIC_ACQUIRE, "agent");
            asm volatile("s_waitcnt vmcnt(0)" ::: "memory");
        }
    }
    __syncthreads();
}
constexpr int NWAVES = 8;
constexpr int RING_OFF = 0, RING_BYTES = 155648;
constexpr int LDSCTL_OFF = RING_BYTES, MISC_OFF = LDSCTL_OFF + 320;
constexpr int LDS_BYTES = RING_BYTES + 1024;
constexpr int CW_TMO = 0, CW_CODE = 1, CW_BAR = 4096;

struct Frame {
    LAS unsigned char* lds;
    volatile LAS unsigned* MISC;
    gu32* ctl;
    int tid, lane, wave, vcu, G;
    const float *x, *meta, *norm1_w, *w_in, *q_norm_w, *k_norm_w, *sinks, *gate_up, *gate_bias, *gla_norm_w, *w_ab, *w_gb, *w_out, *norm2_w, *r_g, *r_e, *e_wg, *e_wu, *e_wd;
    float* out; unsigned char* ws;
};

#ifdef DIAG_MA
#define DG_MARK(F, id) do { if (blockIdx.x == 0 && (F).tid == 0) (F).MISC[16 + (id)] = (unsigned)__builtin_amdgcn_s_memrealtime(); } while (0)
#else
#define DG_MARK(F, id) do {} while (0)
#endif
__device__ __forceinline__ float wave_sum(float v) {
#pragma unroll
    for (int o = 1; o < 64; o <<= 1) v += __shfl_xor(v, o);
    return v;
}

__device__ __forceinline__ void p0_tr_item(const float* W, int ld, int scol0, bf16_t* WT, int Kdst, int drow0, int k0, LAS float* scr, int lane) {
#pragma unroll 8
    for (int i = 0; i < 32; ++i) { const int kk = 2 * i + (lane >> 5); scr[kk * 33 + (lane & 31)] = W[(size_t)(k0 + kk) * ld + scol0 + (lane & 31)]; }
    LDS_WAIT(); asm volatile("" ::: "memory");
    const int c = lane & 7;
#pragma unroll
    for (int j = 0; j < 4; ++j) { const int n = (lane >> 3) + 8 * j; const LAS float* s = scr + (8 * c) * 33 + n;
        v4u o; o.x = pk2(s[0 * 33], s[1 * 33]); o.y = pk2(s[2 * 33], s[3 * 33]); o.z = pk2(s[4 * 33], s[5 * 33]); o.w = pk2(s[6 * 33], s[7 * 33]);
        *(GAS v4u*)(WT + (size_t)(drow0 + n) * Kdst + k0 + 8 * c) = o; }
    LDS_WAIT(); asm volatile("" ::: "memory");
}
struct TrItem { const float* W; int ld, scol0; bf16_t* WT; int Kdst, drow0, k0; };
__device__ __forceinline__ void p0_tr_item2(const TrItem& a, const TrItem& b, bool has_b, LAS float* scr, int lane) {
    LAS float* s0 = scr; LAS float* s1 = scr + 64 * 33;
    float va[32], vb[32];
#pragma unroll
    for (int i = 0; i < 32; ++i) { const int kk = 2 * i + (lane >> 5); va[i] = a.W[(size_t)(a.k0 + kk) * a.ld + a.scol0 + (lane & 31)]; }
    if (has_b) {
#pragma unroll
        for (int i = 0; i < 32; ++i) { const int kk = 2 * i + (lane >> 5); vb[i] = b.W[(size_t)(b.k0 + kk) * b.ld + b.scol0 + (lane & 31)]; } }
#pragma unroll
    for (int i = 0; i < 32; ++i) { const int kk = 2 * i + (lane >> 5); s0[kk * 33 + (lane & 31)] = va[i]; }
    if (has_b) {
#pragma unroll
        for (int i = 0; i < 32; ++i) { const int kk = 2 * i + (lane >> 5); s1[kk * 33 + (lane & 31)] = vb[i]; } }
    LDS_WAIT(); asm volatile("" ::: "memory");
    const int c = lane & 7;
#pragma unroll
    for (int j = 0; j < 4; ++j) { const int n = (lane >> 3) + 8 * j; const LAS float* s = s0 + (8 * c) * 33 + n;
        v4u o; o.x = pk2(s[0 * 33], s[1 * 33]); o.y = pk2(s[2 * 33], s[3 * 33]); o.z = pk2(s[4 * 33], s[5 * 33]); o.w = pk2(s[6 * 33], s[7 * 33]);
        *(GAS v4u*)(a.WT + (size_t)(a.drow0 + n) * a.Kdst + a.k0 + 8 * c) = o; }
    if (has_b) {
#pragma unroll
        for (int j = 0; j < 4; ++j) { const int n = (lane >> 3) + 8 * j; const LAS float* s = s1 + (8 * c) * 33 + n;
            v4u o; o.x = pk2(s[0 * 33], s[1 * 33]); o.y = pk2(s[2 * 33], s[3 * 33]); o.z = pk2(s[4 * 33], s[5 * 33]); o.w = pk2(s[6 * 33], s[7 * 33]);
            *(GAS v4u*)(b.WT + (size_t)(b.drow0 + n) * b.Kdst + b.k0 + 8 * c) = o; } }
    LDS_WAIT(); asm volatile("" ::: "memory");
}
__device__ __forceinline__ void p0_gk_item(const float* w_in, const float* gate_up, int c0, bf16_t* WT, int drow0, int k0, LAS float* scr, int lane) {
#pragma unroll 4
    for (int i = 0; i < 32; ++i) { const int kk = 2 * i + (lane >> 5); const float* wr = w_in + (size_t)(k0 + kk) * INTOT + OFF_GD; float a = 0.f;
#pragma unroll
        for (int r = 0; r < GR; ++r) a += wr[r] * gate_up[r * 256 + c0 + (lane & 31)];
        scr[kk * 33 + (lane & 31)] = a; }
    LDS_WAIT(); asm volatile("" ::: "memory");
    const int c = lane & 7;
#pragma unroll
    for (int j = 0; j < 4; ++j) { const int n = (lane >> 3) + 8 * j; const LAS float* s = scr + (8 * c) * 33 + n;
        v4u o; o.x = pk2(s[0 * 33], s[1 * 33]); o.y = pk2(s[2 * 33], s[3 * 33]); o.z = pk2(s[4 * 33], s[5 * 33]); o.w = pk2(s[6 * 33], s[7 * 33]);
        *(GAS v4u*)(WT + (size_t)(drow0 + n) * 1024 + k0 + 8 * c) = o; }
    LDS_WAIT(); asm volatile("" ::: "memory");
}
__device__ __forceinline__ int wpt_src_col(int n0) {
    const int tile = n0 >> 8, c = n0 & 255, bj = c >> 7, wc = (c & 127) >> 5;
    if (tile < 2) return OFF_QA + (tile * 4 + wc) * 64 + 32 * bj;
    if (tile == 2) return (wc < 2) ? OFF_KA + wc * 64 + 32 * bj : OFF_VA + (wc - 2) * 64 + 32 * bj;
    if (tile == 3) return OFF_QG + c;
    if (tile == 4) return OFF_KG + c;
    if (tile < 7) return OFF_VG + (tile - 5) * 256 + c;
    if (tile < 9) return OFF_RG + (tile - 7) * 256 + c;
    if (tile == 9) return -1;
    return (bj ? OFF_GG : OFF_GA) + (tile - 10) * 128 + (c & 127);
}
__device__ __forceinline__ void rms_row_to_bf16(const float* xrow, const float* w, bf16_t* orow, int lane) {
    const GAS f32x4* xr = (const GAS f32x4*)xrow + lane; const GAS f32x4* wr = (const GAS f32x4*)w + lane;
    f32x4 v[4]; float s = 0.f;
#pragma unroll
    for (int j = 0; j < 4; ++j) { v[j] = xr[64 * j]; s += (v[j].x * v[j].x + v[j].y * v[j].y) + (v[j].z * v[j].z + v[j].w * v[j].w); }
    const float rstd = rsqrtf(wave_sum(s) * (1.f / D) + EPS);
    GAS unsigned long long* o8 = (GAS unsigned long long*)orow + lane;
#pragma unroll
    for (int j = 0; j < 4; ++j) { const f32x4 ww = wr[64 * j];
        o8[64 * j] = (unsigned long long)pk2(v[j].x * rstd * ww.x, v[j].y * rstd * ww.y) | ((unsigned long long)pk2(v[j].z * rstd * ww.z, v[j].w * rstd * ww.w) << 32); }
}
__device__ __forceinline__ void p0_prologue(Frame& F) {
    LAS float* scr = (LAS float*)(F.lds + RING_OFF + F.wave * 16384);
    const int gw = F.vcu * NWAVES + F.wave, NGW = F.G * NWAVES;
    bf16_t* WpT = (bf16_t*)(F.ws + WS_WPT); bf16_t* WbT = (bf16_t*)(F.ws + WS_WBT); bf16_t* WoT = (bf16_t*)(F.ws + WS_WOT); bf16_t* XN = (bf16_t*)(F.ws + WS_XN);
    constexpr int I_P = 16 * (NP / 32), I_B = 8 * 32, I_O = 16 * 32;
    constexpr int NITEMS = I_P + 2 * I_B + I_O;
    for (int it = gw; it < NITEMS; it += NGW) {
        int r = it;
        if (r < I_P) { const int nb = r >> 4, kb = r & 15, sc = wpt_src_col(nb * 32);
            if (sc >= 0) p0_tr_item(F.w_in, INTOT, sc, WpT, 1024, nb * 32, kb * 64, scr, F.lane);
            else p0_gk_item(F.w_in, F.gate_up, (nb * 32) & 255, WpT, nb * 32, kb * 64, scr, F.lane);
            continue; } r -= I_P;
        if (r < I_B) { p0_tr_item(F.w_ab, 1024, (r >> 3) * 32, WbT, 1024, (r >> 3) * 32, (r & 7) * 64, scr, F.lane); continue; } r -= I_B;
        if (r < I_B) { p0_tr_item(F.w_gb, 1024, (r >> 3) * 32, WbT + 512, 1024, (r >> 3) * 32, (r & 7) * 64, scr, F.lane); continue; } r -= I_B;
        p0_tr_item(F.w_out, 1024, (r >> 4) * 32, WoT, 1024, (r >> 4) * 32, (r & 15) * 64, scr, F.lane);
    }
    for (int m = gw; m < MX; m += 4 * NGW) {
        const GAS f32x4* wr = (const GAS f32x4*)F.norm1_w + F.lane;
        f32x4 v[4][4], ww[4]; float a[4];
#pragma unroll
        for (int q = 0; q < 4; ++q) { const int mq = m + q * NGW;
            const float* sp = (mq < M) ? F.x + (size_t)mq * D : F.meta + (size_t)((mq < M + NMETA) ? (mq - M) : 0) * D;
            const GAS f32x4* xq = (const GAS f32x4*)sp + F.lane;
#pragma unroll
            for (int j = 0; j < 4; ++j) v[q][j] = xq[64 * j]; }
#pragma unroll
        for (int j = 0; j < 4; ++j) ww[j] = wr[64 * j];
#pragma unroll
        for (int q = 0; q < 4; ++q) { a[q] = 0.f;
#pragma unroll
            for (int j = 0; j < 4; ++j) a[q] += (v[q][j].x * v[q][j].x + v[q][j].y * v[q][j].y) + (v[q][j].z * v[q][j].z + v[q][j].w * v[q][j].w); }
#pragma unroll
        for (int q = 0; q < 4; ++q) { const int mq = m + q * NGW; if (mq >= MX) continue;
            float r = rsqrtf(wave_sum(a[q]) * (1.f / D) + EPS); if (mq >= M + NMETA) r = 0.f;
            GAS unsigned long long* o = (GAS unsigned long long*)(XN + (size_t)mq * D) + F.lane;
#pragma unroll
            for (int j = 0; j < 4; ++j) o[64 * j] = (unsigned long long)pk2(v[q][j].x * r * ww[j].x, v[q][j].y * r * ww[j].y) | ((unsigned long long)pk2(v[q][j].z * r * ww[j].z, v[q][j].w * r * ww[j].w) << 32); }
    }
    float* rope = (float*)(F.ws + WS_ROPE);
    for (int e = (F.vcu * NWAVES * 64) + F.tid; e < NPOS * 32; e += F.G * NWAVES * 64) {
        const int pos = e >> 5, i = e & 31; const float inv_freq = powf(10000.0f, -((float)(2 * i)) / 64.0f); const float ang = (float)pos * inv_freq;
        rope[2 * e] = cosf(ang); rope[2 * e + 1] = sinf(ang); }
}
__device__ __forceinline__ TrItem expert_item(Frame& F, int r) {
    bf16_t* Wgu = (bf16_t*)(F.ws + WS_WGU); bf16_t* Wd = (bf16_t*)(F.ws + WS_WD);
    constexpr int I_GU = NE * 16 * 16;
    if (r < I_GU) { const int ge = r >> 8, q = r & 255, nb = q >> 4, kb = q & 15;
        const int tn = nb >> 3, bj = (nb >> 2) & 1, qq = nb & 3;
        return TrItem{(bj ? F.e_wu : F.e_wg) + (size_t)ge * D * FF, FF, tn * 128 + qq * 32, Wgu + (size_t)ge * 512 * 1024, 1024, nb * 32, kb * 64}; }
    r -= I_GU;
    const int ge = r >> 7, q = r & 127, nb = q >> 2, kb = q & 3;
    return TrItem{F.e_wd + (size_t)ge * FF * D, D, nb * 32, Wd + (size_t)ge * 1024 * 256, 256, nb * 32, kb * 64};
}
__device__ __forceinline__ void expert_weight_items(Frame& F, int gw, int NGW, int i0, int i1) {
    LAS float* scr = (LAS float*)(F.lds + RING_OFF + F.wave * 16896);
    for (int it = i0 + gw; it < i1; it += 2 * NGW) {
        const bool hb = it + NGW < i1;
        const TrItem a = expert_item(F, it), b = expert_item(F, hb ? it + NGW : it);
        p0_tr_item2(a, b, hb, scr, F.lane);
    }
}
constexpr int EXP_ITEMS_GU = NE * 16 * 16, EXP_ITEMS_ALL = NE * 16 * 16 + NE * 4 * 32;
__device__ __forceinline__ bool attn_valid(int kt, int kr, int i, int qb) {
    if (kt == 0) return kr < 16;
    if (kt < 5) return (qb > 0) && (32 * (kt - 1) + kr > i);
    return 32 * (kt - 5) + kr <= i;
}
__device__ __forceinline__ bool attn_skip(int kt, int i0, int qb) {
    if (kt == 0) return false;
    if (kt < 5) return (qb == 0) || (32 * (kt - 1) + 31 <= i0);
    return 32 * (kt - 5) > i0 + 31;
}
__device__ __forceinline__ void attn_phase(Frame& F) {
    constexpr int KSTR = 144, VSTR = 584;
    LAS unsigned char* Ks = F.lds + RING_OFF; LAS unsigned char* Vt = F.lds + RING_OFF + 288 * KSTR;
    const bf16_t* QA = (const bf16_t*)(F.ws + WS_QA); const bf16_t* KA = (const bf16_t*)(F.ws + WS_KA); const bf16_t* VA = (const bf16_t*)(F.ws + WS_VA); bf16_t* ATT = (bf16_t*)(F.ws + WS_A2);
    const int lane = F.lane, l31 = lane & 31, hh = lane >> 5;
    for (int u = blockIdx.x; u < 256; u += F.G) {
        const int b = u >> 5, kvh = (u >> 4) & 1, qb = u & 15, m0 = b * S + qb * 128;
        v4u kvr[5], vvr[5];
#pragma unroll
        for (int it = 0; it < 5; ++it) {
            const int idx = F.tid + it * NWAVES * 64, slot = idx >> 3, ch = idx & 7;
            int row = -1;
            if (idx < 288 * 8) { if (slot < 16) row = M + slot; else if (slot >= 160) row = m0 + (slot - 160); else if (slot >= 32 && qb > 0) row = m0 - 128 + (slot - 32); }
            kvr[it] = (v4u){0u, 0u, 0u, 0u}; vvr[it] = (v4u){0u, 0u, 0u, 0u};
            if (row >= 0) { kvr[it] = *(const v4u*)(KA + (size_t)row * 128 + kvh * 64 + ch * 8); vvr[it] = *(const v4u*)(VA + (size_t)row * 128 + kvh * 64 + ch * 8); }
        }
#pragma unroll
        for (int it = 0; it < 5; ++it) {
            const int idx = F.tid + it * NWAVES * 64, slot = idx >> 3, ch = idx & 7;
            if (idx < 288 * 8) {
                *(LAS v4u*)(Ks + slot * KSTR + ch * 16) = kvr[it];
#pragma unroll
                for (int e = 0; e < 8; ++e) { const unsigned w = vvr[it][e >> 1]; *(LAS unsigned short*)(Vt + (8 * ch + e) * VSTR + slot * 2) = (unsigned short)((e & 1) ? (w >> 16) : (w & 0xffffu)); }
            }
        }
        __syncthreads();
        const int g = F.wave >> 1, qh = F.wave & 1, head = kvh * 4 + g;
        const float sink = F.sinks[head];
#pragma unroll 1
        for (int blk = 0; blk < 2; ++blk) {
            const int i0 = 64 * qh + 32 * blk, i = i0 + l31;
            bf16x8 qf[4];
#pragma unroll
            for (int ds = 0; ds < 4; ++ds) qf[ds] = *(const bf16x8*)(QA + (size_t)(m0 + i) * 512 + head * 64 + 16 * ds + 8 * hh);
            float mx = -1e30f;
#pragma unroll
            for (int kt = 0; kt < 9; ++kt) {
                if (attn_skip(kt, i0, qb)) continue;
                f32x16 s = {0.f, 0.f, 0.f, 0.f, 0.f, 0.f, 0.f, 0.f, 0.f, 0.f, 0.f, 0.f, 0.f, 0.f, 0.f, 0.f};
#pragma unroll
                for (int ds = 0; ds < 4; ++ds) { const bf16x8 kf = *(const LAS bf16x8*)(Ks + (32 * kt + l31) * KSTR + (16 * ds + 8 * hh) * 2); s = __builtin_amdgcn_mfma_f32_32x32x16_bf16(kf, qf[ds], s, 0, 0, 0); }
#pragma unroll
                for (int r = 0; r < 16; ++r) { const int kr = (r & 3) + 8 * (r >> 2) + 4 * hh; if (attn_valid(kt, kr, i, qb)) mx = fmaxf(mx, s[r]); }
            }
            mx = fmaxf(mx, __shfl_xor(mx, 32)); mx = fmaxf(mx, sink);
            float lsum = 0.f;
            f32x16 o0 = {0.f, 0.f, 0.f, 0.f, 0.f, 0.f, 0.f, 0.f, 0.f, 0.f, 0.f, 0.f, 0.f, 0.f, 0.f, 0.f}, o1 = o0;
#pragma unroll
            for (int kt = 0; kt < 9; ++kt) {
                if (attn_skip(kt, i0, qb)) continue;
                f32x16 s = {0.f, 0.f, 0.f, 0.f, 0.f, 0.f, 0.f, 0.f, 0.f, 0.f, 0.f, 0.f, 0.f, 0.f, 0.f, 0.f};
#pragma unroll
                for (int ds = 0; ds < 4; ++ds) { const bf16x8 kf = *(const LAS bf16x8*)(Ks + (32 * kt + l31) * KSTR + (16 * ds + 8 * hh) * 2); s = __builtin_amdgcn_mfma_f32_32x32x16_bf16(kf, qf[ds], s, 0, 0, 0); }
                float p[16];
#pragma unroll
                for (int r = 0; r < 16; ++r) { const int kr = (r & 3) + 8 * (r >> 2) + 4 * hh; p[r] = attn_valid(kt, kr, i, qb) ? __expf(s[r] - mx) : 0.f; lsum += p[r]; }
#pragma unroll
                for (int s2 = 0; s2 < 2; ++s2) {
                    v4u pw; pw.x = pg8::cvt_pk_bf16(p[8 * s2 + 0], p[8 * s2 + 1]); pw.y = pg8::cvt_pk_bf16(p[8 * s2 + 2], p[8 * s2 + 3]); pw.z = pg8::cvt_pk_bf16(p[8 * s2 + 4], p[8 * s2 + 5]); pw.w = pg8::cvt_pk_bf16(p[8 * s2 + 6], p[8 * s2 + 7]);
                    const bf16x8 pf = __builtin_bit_cast(bf16x8, pw);
#pragma unroll
                    for (int dt = 0; dt < 2; ++dt) {
                        const LAS unsigned char* vp = Vt + (32 * dt + l31) * VSTR + (32 * kt + 16 * s2 + 4 * hh) * 2;
                        const v2u lo = *(const LAS v2u*)vp, hi = *(const LAS v2u*)(vp + 16);
                        const bf16x8 vf = __builtin_bit_cast(bf16x8, (v4u){lo.x, lo.y, hi.x, hi.y});
                        if (dt == 0) o0 = __builtin_amdgcn_mfma_f32_32x32x16_bf16(vf, pf, o0, 0, 0, 0); else o1 = __builtin_amdgcn_mfma_f32_32x32x16_bf16(vf, pf, o1, 0, 0, 0);
                    }
                }
            }
            lsum += __shfl_xor(lsum, 32); lsum += __expf(sink - mx);
            const float inv = 1.0f / lsum;
            bf16_t* orow = ATT + (size_t)(m0 + i) * 1024 + head * 64 + 4 * hh;
#pragma unroll
            for (int rq = 0; rq < 4; ++rq) {
                v2u w0, w1;
                w0.x = pg8::cvt_pk_bf16(o0[4 * rq] * inv, o0[4 * rq + 1] * inv); w0.y = pg8::cvt_pk_bf16(o0[4 * rq + 2] * inv, o0[4 * rq + 3] * inv);
                w1.x = pg8::cvt_pk_bf16(o1[4 * rq] * inv, o1[4 * rq + 1] * inv); w1.y = pg8::cvt_pk_bf16(o1[4 * rq + 2] * inv, o1[4 * rq + 3] * inv);
                *(v2u*)(orow + 8 * rq) = w0; *(v2u*)(orow + 32 + 8 * rq) = w1;
            }
        }
        __syncthreads();
    }
}
__device__ __forceinline__ int crow16(int r, int hh) { return (r & 3) + 8 * (r >> 2) + 4 * hh; }
struct GlaIn { f32x4 g[4]; v4u q[2], k[2], vv[4]; };
__device__ __forceinline__ void gla_a_load(Frame& F, int unit, GlaIn& in) {
    if (unit < 0) return;
    const float* GK = (const float*)(F.ws + WS_GK); const bf16_t* QG = (const bf16_t*)(F.ws + WS_QG); const bf16_t* KG = (const bf16_t*)(F.ws + WS_KG); const bf16_t* VG = (const bf16_t*)(F.ws + WS_VG);
    const bool meta = unit >= 1024; const int bh = meta ? 0 : (unit >> 5), c = unit & 31, h = meta ? (unit - 1024) : (bh & 3), b = bh >> 2;
    const int r0 = meta ? (M - 48) : (b * S + 64 * c);
    const int t = F.lane, dg = F.wave & 3; const bool ok = !meta || t >= 48; const size_t row = (size_t)(r0 + (ok ? t : 48));
#pragma unroll
    for (int i = 0; i < 4; ++i) in.g[i] = *(const f32x4*)(GK + row * 256 + h * 64 + 16 * dg + 4 * i);
#pragma unroll
    for (int i = 0; i < 2; ++i) { in.k[i] = *(const v4u*)(KG + row * 256 + h * 64 + 16 * dg + 8 * i); in.q[i] = meta ? (v4u){0u, 0u, 0u, 0u} : *(const v4u*)(QG + row * 256 + h * 64 + 16 * dg + 8 * i); }
#pragma unroll
    for (int i = 0; i < 4; ++i) in.vv[i] = *(const v4u*)(VG + row * 512 + h * 128 + 32 * dg + 8 * i);
}
__device__ __forceinline__ void gla_a_unit(Frame& F, int unit, const GlaIn& in) {
    constexpr int STR = 144, TEAM_LDS = 49152;
    const int team = F.tid >> 8, tw = F.wave & 3;
    LAS unsigned char* Qt = F.lds + RING_OFF + team * TEAM_LDS; LAS unsigned char* Kt = Qt + 64 * STR; LAS unsigned char* KhT = Kt + 64 * STR; LAS unsigned char* VtT = KhT + 64 * STR;
    bf16_t* QH = (bf16_t*)(F.ws + WS_QH); float* OI = (float*)(F.ws + WS_OI); bf16_t* KV = (bf16_t*)(F.ws + WS_KV); float* DEC = (float*)(F.ws + WS_DEC);
    const bool act = unit >= 0;
    const bool meta = unit >= 1024; const int bh = meta ? 0 : (unit >> 5), c = unit & 31, h = meta ? (unit - 1024) : (bh & 3), b = bh >> 2;
    const int r0 = meta ? (M - 48) : (b * S + 64 * c);
    const int lane = F.lane, l31 = lane & 31, hh = lane >> 5;
    if (act) {
        const int t = lane, dg = tw; const bool ok = !meta || t >= 48;
        float bt[16];
#pragma unroll
        for (int j = 0; j < 16; ++j) bt[j] = ok ? in.g[j >> 2][j & 3] : 0.f;
#pragma unroll
        for (int o = 1; o < 64; o <<= 1) {
#pragma unroll
            for (int j = 0; j < 16; ++j) { const float v = __shfl_up(bt[j], o); if (lane >= o) bt[j] += v; } }
        unsigned qo[8], ko[8], ho[8];
#pragma unroll
        for (int jp = 0; jp < 8; ++jp) {
            float qt2[2], kt2[2], qh2[2];
#pragma unroll
            for (int e = 0; e < 2; ++e) { const int j = 2 * jp + e; const float bmid = __shfl(bt[j], 32), blast = __shfl(bt[j], 63);
                const unsigned qw = in.q[j >> 3][(j >> 1) & 3], kw = in.k[j >> 3][(j >> 1) & 3];
                const float q = ok ? __builtin_bit_cast(float, (j & 1) ? (qw & 0xffff0000u) : (qw << 16)) : 0.f, k = ok ? __builtin_bit_cast(float, (j & 1) ? (kw & 0xffff0000u) : (kw << 16)) : 0.f;
                qt2[e] = q * __expf(bt[j] - bmid); kt2[e] = k * __expf(bmid - bt[j]); qh2[e] = q * __expf(bt[j]);
                *(LAS unsigned short*)(KhT + (16 * dg + j) * STR + t * 2) = (unsigned short)f2bf(k * __expf(blast - bt[j]));
                if (lane == 63) DEC[(size_t)unit * 64 + 16 * dg + j] = __expf(blast); }
            qo[jp] = pk2(qt2[0], qt2[1]); ko[jp] = pk2(kt2[0], kt2[1]); ho[jp] = pk2(qh2[0], qh2[1]);
        }
        *(LAS v4u*)(Qt + t * STR + 32 * dg) = (v4u){qo[0], qo[1], qo[2], qo[3]}; *(LAS v4u*)(Qt + t * STR + 32 * dg + 16) = (v4u){qo[4], qo[5], qo[6], qo[7]};
        *(LAS v4u*)(Kt + t * STR + 32 * dg) = (v4u){ko[0], ko[1], ko[2], ko[3]}; *(LAS v4u*)(Kt + t * STR + 32 * dg + 16) = (v4u){ko[4], ko[5], ko[6], ko[7]};
        if (!meta) { bf16_t* qp = QH + (size_t)(r0 + t) * 256 + h * 64 + 16 * dg; *(v4u*)qp = (v4u){ho[0], ho[1], ho[2], ho[3]}; *(v4u*)(qp + 8) = (v4u){ho[4], ho[5], ho[6], ho[7]}; }
#pragma unroll
        for (int i = 0; i < 4; ++i) { const v4u vv = ok ? in.vv[i] : (v4u){0u, 0u, 0u, 0u};
#pragma unroll
            for (int e = 0; e < 8; ++e) { const unsigned w = vv[e >> 1]; *(LAS unsigned short*)(VtT + (32 * dg + 8 * i + e) * STR + t * 2) = (unsigned short)((e & 1) ? (w >> 16) : (w & 0xffffu)); } }
    }
    __syncthreads();
    if (act) {
        const int iblk = tw & 1;
        if (!meta) {
            bf16x8 pfr[2][2];
#pragma unroll
            for (int jt = 0; jt < 2; ++jt) {
                f32x16 a = {0.f, 0.f, 0.f, 0.f, 0.f, 0.f, 0.f, 0.f, 0.f, 0.f, 0.f, 0.f, 0.f, 0.f, 0.f, 0.f};
                if (jt <= iblk) {
#pragma unroll
                    for (int ds = 0; ds < 4; ++ds) { const bf16x8 kf = *(const LAS bf16x8*)(Kt + (32 * jt + l31) * STR + (16 * ds + 8 * hh) * 2), qf = *(const LAS bf16x8*)(Qt + (32 * iblk + l31) * STR + (16 * ds + 8 * hh) * 2);
                        a = __builtin_amdgcn_mfma_f32_32x32x16_bf16(kf, qf, a, 0, 0, 0); }
                    if (jt == iblk) {
#pragma unroll
                        for (int r = 0; r < 16; ++r) if (crow16(r, hh) > l31) a[r] = 0.f; }
                }
#pragma unroll
                for (int s2 = 0; s2 < 2; ++s2) { v4u pw; pw.x = pg8::cvt_pk_bf16(a[8 * s2 + 0], a[8 * s2 + 1]); pw.y = pg8::cvt_pk_bf16(a[8 * s2 + 2], a[8 * s2 + 3]); pw.z = pg8::cvt_pk_bf16(a[8 * s2 + 4], a[8 * s2 + 5]); pw.w = pg8::cvt_pk_bf16(a[8 * s2 + 6], a[8 * s2 + 7]);
                    pfr[jt][s2] = __builtin_bit_cast(bf16x8, pw); }
            }
#pragma unroll
            for (int vi = 0; vi < 2; ++vi) {
                const int vt = (tw >> 1) + 2 * vi;
                f32x16 oacc = {0.f, 0.f, 0.f, 0.f, 0.f, 0.f, 0.f, 0.f, 0.f, 0.f, 0.f, 0.f, 0.f, 0.f, 0.f, 0.f};
#pragma unroll
                for (int jt = 0; jt < 2; ++jt) {
                    if (jt > iblk) continue;
#pragma unroll
                    for (int s2 = 0; s2 < 2; ++s2) {
                        const LAS unsigned char* vp = VtT + (32 * vt + l31) * STR + (32 * jt + 16 * s2 + 4 * hh) * 2;
                        const v2u lo = *(const LAS v2u*)vp, hi = *(const LAS v2u*)(vp + 16);
                        oacc = __builtin_amdgcn_mfma_f32_32x32x16_bf16(__builtin_bit_cast(bf16x8, (v4u){lo.x, lo.y, hi.x, hi.y}), pfr[jt][s2], oacc, 0, 0, 0);
                    }
                }
                float* op = OI + ((size_t)unit * 8 + ((vt << 1) | iblk)) * 1024 + lane * 16;
#pragma unroll
                for (int r4 = 0; r4 < 4; ++r4) *(f32x4*)(op + 4 * r4) = (f32x4){oacc[4 * r4], oacc[4 * r4 + 1], oacc[4 * r4 + 2], oacc[4 * r4 + 3]};
            }
        }
        const int dblk = tw & 1;
#pragma unroll
        for (int vi = 0; vi < 2; ++vi) {
            const int vt = (tw >> 1) + 2 * vi;
            f32x16 kv = {0.f, 0.f, 0.f, 0.f, 0.f, 0.f, 0.f, 0.f, 0.f, 0.f, 0.f, 0.f, 0.f, 0.f, 0.f, 0.f};
#pragma unroll
            for (int s = 0; s < 4; ++s) { const bf16x8 vf = *(const LAS bf16x8*)(VtT + (32 * vt + l31) * STR + (16 * s + 8 * hh) * 2), kf = *(const LAS bf16x8*)(KhT + (32 * dblk + l31) * STR + (16 * s + 8 * hh) * 2);
                kv = __builtin_amdgcn_mfma_f32_32x32x16_bf16(vf, kf, kv, 0, 0, 0); }
            bf16_t* kp = KV + (size_t)unit * 8192 + 32 * dblk + l31;
#pragma unroll
            for (int r = 0; r < 16; ++r) kp[(32 * vt + crow16(r, hh)) * 64] = (bf16_t)f2bf(kv[r]);
        }
    }
    __syncthreads();
}
__device__ __forceinline__ void gla_scan_phase(Frame& F) {
    typedef float f32x2 __attribute__((ext_vector_type(2)));
    const bf16_t* KV = (const bf16_t*)(F.ws + WS_KV); const float* DEC = (const float*)(F.ws + WS_DEC); bf16_t* St = (bf16_t*)(F.ws + WS_ST);
    for (int e = F.vcu * NWAVES * 64 + F.tid; e < 32 * 4096; e += F.G * NWAVES * 64) {
        const int bh = e >> 12, p = e & 4095, v = p >> 5, d2 = (p & 31) * 2, h = bh & 3;
        f32x2 s; { const unsigned w0 = *(const unsigned*)(KV + (size_t)(1024 + h) * 8192 + v * 64 + d2); s.x = __builtin_bit_cast(float, w0 << 16); s.y = __builtin_bit_cast(float, w0 & 0xffff0000u); }
#pragma unroll 1
        for (int cb = 0; cb < 4; ++cb) {
            f32x2 kvv[8], dcv[8];
#pragma unroll
            for (int j = 0; j < 8; ++j) { const size_t unit = (size_t)bh * 32 + cb * 8 + j; dcv[j] = *(const f32x2*)(DEC + unit * 64 + d2); const unsigned w0 = *(const unsigned*)(KV + unit * 8192 + v * 64 + d2); kvv[j].x = __builtin_bit_cast(float, w0 << 16); kvv[j].y = __builtin_bit_cast(float, w0 & 0xffff0000u); }
            unsigned st[8];
#pragma unroll
            for (int j = 0; j < 8; ++j) { st[j] = pk2(s.x, s.y); s = dcv[j] * s + kvv[j]; }
#pragma unroll
            for (int j = 0; j < 8; ++j) { const size_t unit = (size_t)bh * 32 + cb * 8 + j; *(unsigned*)(St + unit * 8192 + v * 64 + d2) = st[j]; }
        }
    }
}
__device__ __forceinline__ void gla_c_phase(Frame& F) {
    const bf16_t* QH = (const bf16_t*)(F.ws + WS_QH); const float* OI = (const float*)(F.ws + WS_OI); const bf16_t* St = (const bf16_t*)(F.ws + WS_ST); const bf16_t* RG = (const bf16_t*)(F.ws + WS_RG);
    bf16_t* OG = (bf16_t*)(F.ws + WS_A2) + 512;
    const int lane = F.lane, l31 = lane & 31, hh = lane >> 5, w = F.wave;
    f32x4 w4v[4][4];
#pragma unroll
    for (int vt = 0; vt < 4; ++vt)
#pragma unroll
        for (int rq = 0; rq < 4; ++rq) w4v[vt][rq] = *(const f32x4*)(F.gla_norm_w + 32 * vt + 8 * rq + 4 * hh);
    for (int u = blockIdx.x; u < 256; u += F.G) {
        const int bh = u >> 3, cg = u & 7, b = bh >> 2, h = bh & 3, c = 4 * cg + (w >> 1), iblk = w & 1;
        const size_t unit = (size_t)bh * 32 + c; const int row = b * S + 64 * c + 32 * iblk + l31;
        bf16x8 qf[4];
#pragma unroll
        for (int s = 0; s < 4; ++s) qf[s] = *(const bf16x8*)(QH + (size_t)row * 256 + h * 64 + 16 * s + 8 * hh);
        v2u rgv[4][4];
#pragma unroll
        for (int vt = 0; vt < 4; ++vt)
#pragma unroll
            for (int rq = 0; rq < 4; ++rq) rgv[vt][rq] = *(const v2u*)(RG + (size_t)row * 512 + h * 128 + 32 * vt + 8 * rq + 4 * hh);
        f32x16 acc[4]; float ss = 0.f;
#pragma unroll
        for (int vt = 0; vt < 4; ++vt) {
            const float* op = OI + (unit * 8 + vt * 2 + iblk) * 1024 + lane * 16;
#pragma unroll
            for (int r4 = 0; r4 < 4; ++r4) { const f32x4 t4 = *(const f32x4*)(op + 4 * r4); acc[vt][4 * r4] = t4[0]; acc[vt][4 * r4 + 1] = t4[1]; acc[vt][4 * r4 + 2] = t4[2]; acc[vt][4 * r4 + 3] = t4[3]; }
#pragma unroll
            for (int s = 0; s < 4; ++s) { const bf16x8 sf = *(const bf16x8*)(St + unit * 8192 + (32 * vt + l31) * 64 + 16 * s + 8 * hh); acc[vt] = __builtin_amdgcn_mfma_f32_32x32x16_bf16(sf, qf[s], acc[vt], 0, 0, 0); }
#pragma unroll
            for (int r = 0; r < 16; ++r) ss += acc[vt][r] * acc[vt][r];
        }
        ss += __shfl_xor(ss, 32);
        const float rstd = rsqrtf(ss * (1.0f / 128.0f) + EPS);
#pragma unroll
        for (int vt = 0; vt < 4; ++vt)
#pragma unroll
            for (int rq = 0; rq < 4; ++rq) { const int v0 = 32 * vt + 8 * rq + 4 * hh;
                const f32x4 w4 = w4v[vt][rq]; const v2u rg = rgv[vt][rq];
                const float o0 = acc[vt][4 * rq + 0] * rstd * w4[0] * __builtin_bit_cast(float, rg.x << 16), o1 = acc[vt][4 * rq + 1] * rstd * w4[1] * __builtin_bit_cast(float, rg.x & 0xffff0000u);
                const float o2 = acc[vt][4 * rq + 2] * rstd * w4[2] * __builtin_bit_cast(float, rg.y << 16), o3 = acc[vt][4 * rq + 3] * rstd * w4[3] * __builtin_bit_cast(float, rg.y & 0xffff0000u);
                v2u o; o.x = pg8::cvt_pk_bf16(o0, o1); o.y = pg8::cvt_pk_bf16(o2, o3);
                *(v2u*)(OG + (size_t)row * 1024 + h * 128 + v0) = o; }
    }
}
constexpr size_t WS_WRT = WS_ROPE + 640 * 1024;
constexpr size_t WS_XN2 = WS_MG;
constexpr size_t WS_HID = WS_RG;
constexpr size_t WS_EL  = WS_GK;
constexpr size_t WS_EW  = WS_EL + 2 * MiB;
constexpr size_t WS_PL  = WS_EW + 2 * MiB;
constexpr size_t WS_TI  = WS_PL + 7 * MiB;
static_assert(WS_TI + (size_t)M * 4 <= WS_A2, "MoE lists inside the dead GK region");
constexpr int CW_ECNT = 12288, CSTR = 32;
constexpr int LCAP = 16384;

__device__ __forceinline__ void p0_router_weights(Frame& F) {
    bf16_t* Whi = (bf16_t*)(F.ws + WS_WRT); bf16_t* Wlo = Whi + 48 * 1024;
    for (int e = F.vcu * NWAVES * 64 + F.tid; e < 48 * 1024; e += F.G * NWAVES * 64) {
        const int n = e >> 10, d = e & 1023; float v = 0.f;
        if (n < 4) v = F.r_g[(size_t)d * NG + n]; else if (n < 36) { const int g = (n - 4) >> 3, ex = (n - 4) & 7; v = F.r_e[((size_t)g * D + d) * EPG + ex]; }
        v *= F.norm2_w[d];
        const unsigned hi = f2bf(v); const float rem = v - __builtin_bit_cast(float, hi << 16);
        Whi[e] = (bf16_t)hi; Wlo[e] = (bf16_t)f2bf(rem); }
}
__device__ __forceinline__ void router_phase(Frame& F) {
    LAS float* lg = (LAS float*)(F.lds + RING_OFF);
    LAS float* lgs = lg + 8 * 64 * 48;
    LAS float* ssq = lgs + 64 * 48;
    LAS int* hist = (LAS int*)(ssq + 512);
    LAS int* base = hist + 144;
    LAS float* rstd_s = (LAS float*)(base + 144);
    const float* WrT = (const float*)(F.ws + WS_WRT); const float* H = F.out; bf16_t* XN2 = (bf16_t*)(F.ws + WS_XN2);
    int* EL = (int*)(F.ws + WS_EL); float* EW = (float*)(F.ws + WS_EW); int* PL = (int*)(F.ws + WS_PL); int* TI = (int*)(F.ws + WS_TI);
    unsigned* gcnt = (unsigned*)(F.ctl + CW_ECNT);
    const int tid = F.tid, lane = F.lane, w = F.wave;
    for (int tile = blockIdx.x; tile < M / 64; tile += F.G) {
        const int t0 = tile * 64;
        DG_MARK(F, 0);
        if (tid < 144) hist[tid] = 0;
        {
            const int tk = lane & 15, q = lane >> 4;
            const float* hp = H + (size_t)(t0 + tk) * D + 128 * w + 8 * q;
            const bf16_t* whp = (const bf16_t*)(F.ws + WS_WRT) + (size_t)tk * D + 128 * w + 8 * q; const bf16_t* wlp = whp + 48 * 1024;
            f32x4 acc[4][3]; float ss[4];
#pragma unroll
            for (int tt = 0; tt < 4; ++tt) { ss[tt] = 0.f;
#pragma unroll
                for (int nt = 0; nt < 3; ++nt) acc[tt][nt] = (f32x4){0.f, 0.f, 0.f, 0.f}; }
#pragma unroll 2
            for (int ks = 0; ks < 4; ++ks) {
                bf16x8 wh[3], wl[3]; f32x4 hv[4][2];
#pragma unroll
                for (int nt = 0; nt < 3; ++nt) { wh[nt] = *(const bf16x8*)(whp + nt * 16 * D + 32 * ks); wl[nt] = *(const bf16x8*)(wlp + nt * 16 * D + 32 * ks); }
#pragma unroll
                for (int tt = 0; tt < 4; ++tt) { hv[tt][0] = *(const f32x4*)(hp + (size_t)tt * 16 * D + 32 * ks); hv[tt][1] = *(const f32x4*)(hp + (size_t)tt * 16 * D + 32 * ks + 4); }
#pragma unroll
                for (int tt = 0; tt < 4; ++tt) {
                    const f32x4 x0 = hv[tt][0], x1 = hv[tt][1];
                    ss[tt] += (x0[0] * x0[0] + x0[1] * x0[1]) + (x0[2] * x0[2] + x0[3] * x0[3]) + (x1[0] * x1[0] + x1[1] * x1[1]) + (x1[2] * x1[2] + x1[3] * x1[3]);
                    unsigned hb[8]; float lo[8];
#pragma unroll
                    for (int e = 0; e < 4; ++e) { hb[e] = f2bf(x0[e]); lo[e] = x0[e] - __builtin_bit_cast(float, hb[e] << 16); hb[4 + e] = f2bf(x1[e]); lo[4 + e] = x1[e] - __builtin_bit_cast(float, hb[4 + e] << 16); }
                    v4u hw, lw;
                    hw.x = hb[0] | (hb[1] << 16); hw.y = hb[2] | (hb[3] << 16); hw.z = hb[4] | (hb[5] << 16); hw.w = hb[6] | (hb[7] << 16);
                    lw.x = pk2(lo[0], lo[1]); lw.y = pk2(lo[2], lo[3]); lw.z = pk2(lo[4], lo[5]); lw.w = pk2(lo[6], lo[7]);
                    const bf16x8 hh8 = __builtin_bit_cast(bf16x8, hw), hl8 = __builtin_bit_cast(bf16x8, lw);
#pragma unroll
                    for (int nt = 0; nt < 3; ++nt) {
                        acc[tt][nt] = __builtin_amdgcn_mfma_f32_16x16x32_bf16(wh[nt], hh8, acc[tt][nt], 0, 0, 0);
                        acc[tt][nt] = __builtin_amdgcn_mfma_f32_16x16x32_bf16(wh[nt], hl8, acc[tt][nt], 0, 0, 0);
                        acc[tt][nt] = __builtin_amdgcn_mfma_f32_16x16x32_bf16(wl[nt], hh8, acc[tt][nt], 0, 0, 0); }
                }
            }
#pragma unroll
            for (int tt = 0; tt < 4; ++tt) {
                float s1 = ss[tt]; s1 += __shfl_xor(s1, 16); s1 += __shfl_xor(s1, 32);
                if (q == 0) ssq[w * 64 + 16 * tt + tk] = s1;
                LAS float* lp = lg + (w * 64 + 16 * tt + tk) * 48 + 4 * q;
#pragma unroll
                for (int nt = 0; nt < 3; ++nt)
#pragma unroll
                    for (int r = 0; r < 4; ++r) lp[16 * nt + r] = acc[tt][nt][r];
            }
        }
        __syncthreads();
        {
            const int token = tid & 63, part = tid >> 6;
#pragma unroll
            for (int i = 0; i < 6; ++i) { float a = 0.f;
#pragma unroll
                for (int ww = 0; ww < 8; ++ww) a += lg[(ww * 64 + token) * 48 + 6 * part + i];
                lgs[token * 48 + 6 * part + i] = a; }
            if (part == 0) { float a = 0.f;
#pragma unroll
                for (int ww = 0; ww < 8; ++ww) a += ssq[ww * 64 + token];
                ssq[token] = a; }
        }
        __syncthreads();
        DG_MARK(F, 1);
        int ge_lo = 0, ge_hi = 0, pr = 0, rk_lo = 0, rk_hi = 0, rk_p = 0; float w_lo = 0.f, w_hi = 0.f;
        if (tid < 64) {
            const float rs = rsqrtf(ssq[tid] * (1.0f / D) + EPS); rstd_s[tid] = rs;
            const LAS float* l0 = lgs + tid * 48;
            int g = 0; float mx = l0[0] * rs; float gl[4]; gl[0] = mx;
#pragma unroll
            for (int i = 1; i < 4; ++i) { gl[i] = l0[i] * rs; if (gl[i] > mx) { mx = gl[i]; g = i; } }
            float den = 0.f;
#pragma unroll
            for (int i = 0; i < 4; ++i) den += expf(gl[i] - mx);
            const float gw = 1.0f / den;
            int e1 = 0; float v1 = l0[4 + 8 * g] * rs; float el[8]; el[0] = v1;
#pragma unroll
            for (int i = 1; i < 8; ++i) { el[i] = l0[4 + 8 * g + i] * rs; if (el[i] > v1) { v1 = el[i]; e1 = i; } }
            int e2 = -1; float v2 = -3.0e38f;
#pragma unroll
            for (int i = 0; i < 8; ++i) if (i != e1 && el[i] > v2) { v2 = el[i]; e2 = i; }
            const float p2 = expf(v2 - v1), dn = 1.0f / (1.0f + p2); const float w1 = gw * dn, w2 = gw * p2 * dn;
            const int elo = e1 < e2 ? e1 : e2, ehi = e1 < e2 ? e2 : e1; w_lo = e1 < e2 ? w1 : w2; w_hi = e1 < e2 ? w2 : w1;
            ge_lo = 8 * g + elo; ge_hi = 8 * g + ehi; pr = g * 28 + (elo * (15 - elo)) / 2 + (ehi - elo - 1);
            rk_lo = atomicAdd((int*)(hist + ge_lo), 1); rk_hi = atomicAdd((int*)(hist + ge_hi), 1); rk_p = atomicAdd((int*)(hist + 32 + pr), 1);
        }
        __syncthreads();
        if (tid < 144) { const int c = hist[tid]; base[tid] = c ? (int)atomicAdd(gcnt + CSTR * tid, (unsigned)c) : 0; }
        __syncthreads();
        if (tid < 64) {
            const int token = t0 + tid;
            const int plo = base[ge_lo] + rk_lo, phi = base[ge_hi] + rk_hi, pp = base[32 + pr] + rk_p;
            EL[(size_t)ge_lo * LCAP + plo] = token; EW[(size_t)ge_lo * LCAP + plo] = w_lo;
            EL[(size_t)ge_hi * LCAP + phi] = token | (1 << 16); EW[(size_t)ge_hi * LCAP + phi] = w_hi;
            PL[(size_t)pr * LCAP + pp] = token; TI[token] = ge_lo | (ge_hi << 8);
        }
        DG_MARK(F, 2);
        {
            const f32x4* wr = (const f32x4*)F.norm2_w + lane; f32x4 ww[4];
#pragma unroll
            for (int j = 0; j < 4; ++j) ww[j] = wr[64 * j];
#pragma unroll 1
            for (int i = w; i < 64; i += 4 * NWAVES) {
                f32x4 v[4][4];
#pragma unroll
                for (int q = 0; q < 4; ++q) { const f32x4* xr = (const f32x4*)(H + (size_t)(t0 + i + 8 * q) * D) + lane;
#pragma unroll
                    for (int j = 0; j < 4; ++j) v[q][j] = xr[64 * j]; }
#pragma unroll
                for (int q = 0; q < 4; ++q) { const float rs = rstd_s[i + 8 * q]; unsigned long long* o8 = (unsigned long long*)(XN2 + (size_t)(t0 + i + 8 * q) * D) + lane;
#pragma unroll
                    for (int j = 0; j < 4; ++j) o8[64 * j] = (unsigned long long)pk2(v[q][j][0] * rs * ww[j][0], v[q][j][1] * rs * ww[j][1]) | ((unsigned long long)pk2(v[q][j][2] * rs * ww[j][2], v[q][j][3] * rs * ww[j][3]) << 32); }
            }
        }
        __syncthreads();
        DG_MARK(F, 3);
    }
}
namespace mg {
constexpr int BUFB = 49152, NBUF = 3, INFO_OFF = NBUF * BUFB;
template <bool PERM, class BSel, class Epi>
__device__ __forceinline__ void tile(LAS unsigned char* lds, const bf16_t* A, int lda, int ldb, int nk, int nseg, const BSel& Bsel, const Epi& E) {
    const int tid = threadIdx.x, wid = __builtin_amdgcn_readfirstlane(tid >> 6), lane = tid & 63, wr = wid >> 2, wc = wid & 3, fr = lane & 15, fq = lane >> 4;
    const LAS int* rows = (const LAS int*)(lds + INFO_OFF);
    unsigned aoffv[2], boffv[2];
#pragma unroll
    for (int i = 0; i < 2; ++i) { int R, C; pg8::stage_rc(tid * 16 + i * 8192, R, C); const int Rb = PERM ? ((R & ~31) + pg8::perm32(R & 31)) : R;
        aoffv[i] = (unsigned)(rows[R] * lda + C) * 2u; boffv[i] = (unsigned)(Rb * ldb + C) * 2u; }
    const unsigned ldsw = (unsigned)wid * 1024u; const size_t bhalf = (size_t)128 * ldb * 2;
    const int aoff = pg8::lds_byte(wr * 64 + fr, fq * 8), boff = pg8::lds_byte(wc * 32 + fr, fq * 8);
    const int nsteps = nk * nseg;
#define MG_STAGE(j) do { const int sg_ = (j) / nk, kt_ = (j) - sg_ * nk, b_ = (j) % NBUF; const char* ap_ = (const char*)A + (size_t)kt_ * 128; const char* bp_ = (const char*)Bsel(sg_, kt_); \
        _Pragma("unroll") for (int i_ = 0; i_ < 2; ++i_) __builtin_amdgcn_global_load_lds((const unsigned*)(ap_ + aoffv[i_]), (LAS unsigned*)(lds + b_ * BUFB + ldsw + i_ * 8192), 16, 0, 0); \
        _Pragma("unroll") for (int h_ = 0; h_ < 2; ++h_) _Pragma("unroll") for (int i_ = 0; i_ < 2; ++i_) \
            __builtin_amdgcn_global_load_lds((const unsigned*)(bp_ + h_ * bhalf + boffv[i_]), (LAS unsigned*)(lds + b_ * BUFB + 16384 + h_ * 16384 + ldsw + i_ * 8192), 16, 0, 0); } while (0)
    f32x4 acc[2][4][2];
#pragma unroll
    for (int b = 0; b < 2; ++b)
#pragma unroll
        for (int m = 0; m < 4; ++m)
#pragma unroll
            for (int n = 0; n < 2; ++n) acc[b][m][n] = (f32x4){0.f, 0.f, 0.f, 0.f};
    MG_STAGE(0); MG_STAGE(1);
    int kseg = 0, sg = 0;
    for (int j = 0; j < nsteps; ++j) {
        const int cb = j % NBUF;
        if (j + 1 < nsteps) asm volatile("s_waitcnt vmcnt(6)" ::: "memory"); else asm volatile("s_waitcnt vmcnt(0)" ::: "memory");
        __builtin_amdgcn_s_barrier(); __builtin_amdgcn_sched_barrier(0);
        if (j + 2 < nsteps) MG_STAGE(j + 2);
        bf16x8 At[4][2], Bt[2][2][2];
        const LAS unsigned char* pa = lds + cb * BUFB + aoff; const LAS unsigned char* pb = lds + cb * BUFB + 16384 + boff;
#pragma unroll
        for (int m = 0; m < 4; ++m)
#pragma unroll
            for (int k = 0; k < 2; ++k) At[m][k] = *(const LAS bf16x8*)(pa + m * 2048 + k * 1024);
#pragma unroll
        for (int bj = 0; bj < 2; ++bj)
#pragma unroll
            for (int n = 0; n < 2; ++n)
#pragma unroll
                for (int k = 0; k < 2; ++k) Bt[bj][n][k] = *(const LAS bf16x8*)(pb + bj * 16384 + n * 2048 + k * 1024);
        __builtin_amdgcn_s_setprio(1);
#pragma unroll
        for (int bj = 0; bj < 2; ++bj)
#pragma unroll
            for (int m = 0; m < 4; ++m)
#pragma unroll
                for (int n = 0; n < 2; ++n)
#pragma unroll
                    for (int k = 0; k < 2; ++k) acc[bj][m][n] = __builtin_amdgcn_mfma_f32_16x16x32_bf16(Bt[bj][n][k], At[m][k], acc[bj][m][n], 0, 0, 0);
        __builtin_amdgcn_s_setprio(0);
        __builtin_amdgcn_sched_barrier(0);
        if (++kseg == nk) {
            E(acc, sg, wr, wc, fr, fq); kseg = 0; ++sg;
#pragma unroll
            for (int b = 0; b < 2; ++b)
#pragma unroll
                for (int m = 0; m < 4; ++m)
#pragma unroll
                    for (int n = 0; n < 2; ++n) acc[b][m][n] = (f32x4){0.f, 0.f, 0.f, 0.f};
        }
    }
#undef MG_STAGE
    asm volatile("s_waitcnt lgkmcnt(0)" ::: "memory"); __builtin_amdgcn_s_barrier();
}
}

struct EpiMoe1 {
    LAS unsigned char* lds; bf16_t* HID; int tn, nvalid;
    __device__ __forceinline__ void operator()(const f32x4 (&acc)[2][4][2], int sg, int wr, int wc, int fr, int fq) const {
        const LAS int* rows = (const LAS int*)(lds + mg::INFO_OFF); const LAS float* wts = (const LAS float*)(lds + mg::INFO_OFF + 512); const LAS int* aux = (const LAS int*)(lds + mg::INFO_OFF + 1024);
#pragma unroll
        for (int m = 0; m < 4; ++m) { const int r = wr * 64 + m * 16 + fr; if (r >= nvalid) continue;
            const float cw = wts[r]; f32x4 h0, h1;
#pragma unroll
            for (int j = 0; j < 4; ++j) { const float g0 = acc[0][m][0][j], g1 = acc[0][m][1][j]; h0[j] = g0 * fast_sigmoid(g0) * acc[1][m][0][j] * cw; h1[j] = g1 * fast_sigmoid(g1) * acc[1][m][1][j] * cw; }
            *(v4u*)(HID + (size_t)rows[r] * 512 + aux[r] * 256 + tn * 128 + wc * 32 + 8 * fq) = pg8::pack8(h0, h1); }
    }
};
struct EpiMoe2 {
    LAS unsigned char* lds; float* O; int nvalid;
    __device__ __forceinline__ void operator()(const f32x4 (&acc)[2][4][2], int tn, int wr, int wc, int fr, int fq) const {
        const LAS int* rows = (const LAS int*)(lds + mg::INFO_OFF);
        f32x4 hv[4][2][2];
#pragma unroll
        for (int m = 0; m < 4; ++m) { const int r = wr * 64 + m * 16 + fr; const float* op = O + (size_t)rows[r] * D + tn * 256 + wc * 32 + 4 * fq;
#pragma unroll
            for (int bj = 0; bj < 2; ++bj)
#pragma unroll
                for (int n = 0; n < 2; ++n) hv[m][bj][n] = *(const f32x4*)(op + bj * 128 + n * 16); }
#pragma unroll
        for (int m = 0; m < 4; ++m) { const int r = wr * 64 + m * 16 + fr; if (r >= nvalid) continue;
            float* op = O + (size_t)rows[r] * D + tn * 256 + wc * 32 + 4 * fq;
#pragma unroll
            for (int bj = 0; bj < 2; ++bj)
#pragma unroll
                for (int n = 0; n < 2; ++n) *(f32x4*)(op + bj * 128 + n * 16) = hv[m][bj][n] + acc[bj][m][n]; }
    }
};
__device__ __forceinline__ void moe1_phase(Frame& F) {
    LAS int* pre = (LAS int*)(F.lds + RING_OFF + 143360);
    const unsigned* gcnt = (const unsigned*)(F.ctl + CW_ECNT);
    if (F.tid == 0) { int a = 0; for (int e = 0; e < NE; ++e) { pre[e] = a; a += (((int)gcnt[CSTR * e] + 255) >> 8) * 2; } pre[NE] = a; }
    __syncthreads();
    pg8::Gemm g{(const bf16_t*)(F.ws + WS_XN2), (const bf16_t*)(F.ws + WS_WGU), M, NE * 512, D, D, D};
    pg8::MoeOrder So{F.G, F.vcu, pre, gcnt, CSTR, (const int*)(F.ws + WS_EL)};
    pg8::EpiMoe1g E{(const int*)(F.ws + WS_EL), (const float*)(F.ws + WS_EW), (bf16_t*)(F.ws + WS_HID)};
    pg8::gemm_phase<pg8::EpiMoe1g, pg8::MoeOrder, true, true, true>(F.lds + RING_OFF, g, So, E);
    __syncthreads();
    {
        const int total = pre[NE], first = (total > F.G) ? (total - F.G) : 0;
        if (F.vcu >= first) expert_weight_items(F, (F.vcu - first) * NWAVES + F.wave, (F.G - first) * NWAVES, EXP_ITEMS_GU, EXP_ITEMS_ALL);
    }
    __syncthreads();
}
__device__ __forceinline__ void moe2_phase_simple(Frame& F) {
    LAS unsigned char* lds = F.lds + RING_OFF;
    LAS int* pre = (LAS int*)(lds + mg::INFO_OFF + 2048);
    const unsigned* pcnt = (const unsigned*)(F.ctl + CW_ECNT) + CSTR * 32;
    const int* PL = (const int*)(F.ws + WS_PL);
    if (F.tid == 0) { int a = 0; for (int p = 0; p < 112; ++p) { pre[p] = a; a += (((int)pcnt[CSTR * p] + 127) >> 7); } pre[112] = a; }
    __syncthreads();
    const int total = pre[112];
    for (int u = F.vcu; u < total; u += F.G) {
        int p = 0; while (p < 111 && u >= pre[p + 1]) ++p;
        const int mt = u - pre[p], cnt = (int)pcnt[CSTR * p], nvalid = (cnt - mt * 128 < 128) ? (cnt - mt * 128) : 128;
        const int g = p / 28; int pi = p - g * 28, elo = 0; while (pi >= 7 - elo) { pi -= 7 - elo; ++elo; } const int ehi = elo + 1 + pi;
        __syncthreads();
        if (F.tid < 128) ((LAS int*)(lds + mg::INFO_OFF))[F.tid] = PL[(size_t)p * LCAP + mt * 128 + ((F.tid < nvalid) ? F.tid : 0)];
        __syncthreads();
        const bf16_t* B0 = (const bf16_t*)(F.ws + WS_WD) + (size_t)(8 * g + elo) * 1024 * 256;
        const bf16_t* B1 = (const bf16_t*)(F.ws + WS_WD) + (size_t)(8 * g + ehi) * 1024 * 256;
        EpiMoe2 E{lds, F.out, nvalid};
        auto bsel = [B0, B1](int tn, int kt) { return (kt < 4 ? B0 + (size_t)kt * 64 : B1 + (size_t)(kt - 4) * 64) + (size_t)tn * 256 * 256; };
        mg::tile<false>(lds, (const bf16_t*)(F.ws + WS_HID), 512, 256, 8, 4, bsel, E);
    }
    __syncthreads();
}

__device__ __forceinline__ void moe2_phase(Frame& F) {
    LAS int* pre = (LAS int*)(F.lds + RING_OFF + 143360);
    const unsigned* pcnt = (const unsigned*)(F.ctl + CW_ECNT) + CSTR * 32;
    if (F.tid == 0) { int a = 0; for (int p = 0; p < 112; ++p) { pre[p] = a; a += (((int)pcnt[CSTR * p] + 255) >> 8) * 4; } pre[112] = a; }
    __syncthreads();
    pg8::Gemm g{(const bf16_t*)(F.ws + WS_HID), (const bf16_t*)(F.ws + WS_WD), M, NE * 1024, 512, 512, 256};
    pg8::Moe2Order So{F.G, F.vcu, pre, pcnt, CSTR, (const int*)(F.ws + WS_PL)};
    pg8::EpiMoe2g E{(const int*)(F.ws + WS_PL), F.out};
    pg8::gemm_phase<pg8::EpiMoe2g, pg8::Moe2Order, false, true, true>(F.lds + RING_OFF, g, So, E);
    __syncthreads();
}
__global__ void __launch_bounds__(64) s_attn(const bf16_t* __restrict__ QA, const bf16_t* __restrict__ KA, const bf16_t* __restrict__ VA, const float* __restrict__ sinks, bf16_t* __restrict__ ATT) {
    const int m = blockIdx.x, h = blockIdx.y, kvh = h >> 2, lane = threadIdx.x, s = m & (S - 1);
    __shared__ float q[64]; __shared__ float sc[160];
    q[lane] = bf2f(QA[(size_t)m * 512 + h * 64 + lane]);
    __syncthreads();
    const int j0 = (s - 127 > 0) ? (s - 127) : 0; const int nband = s - j0 + 1, nk = NMETA + nband;
    for (int i = lane; i < nk; i += 64) {
        const int kr = (i < NMETA) ? (M + i) : (m - s + j0 + (i - NMETA));
        const bf16_t* kp = KA + (size_t)kr * 128 + kvh * 64;
        float a = 0.f;
        for (int d = 0; d < 64; ++d) a += q[d] * bf2f(kp[d]);
        sc[i] = a;
    }
    __syncthreads();
    const float sk = sinks[h];
    float mx = sk;
    for (int i = 0; i < nk; ++i) mx = fmaxf(mx, sc[i]);
    float den = expf(sk - mx), o = 0.f;
    for (int i = 0; i < nk; ++i) {
        const int kr = (i < NMETA) ? (M + i) : (m - s + j0 + (i - NMETA));
        const float p = expf(sc[i] - mx); den += p; o += p * bf2f(VA[(size_t)kr * 128 + kvh * 64 + lane]);
    }
    ATT[(size_t)m * 512 + h * 64 + lane] = (bf16_t)f2bf(o / den);
}
__global__ void __launch_bounds__(128) s_gla(const bf16_t* __restrict__ QG, const bf16_t* __restrict__ KG, const bf16_t* __restrict__ VG, const float* __restrict__ GK, float* __restrict__ O) {
    const int b = blockIdx.x >> 2, h = blockIdx.x & 3, v = threadIdx.x;
    __shared__ float sq[64], sk[64], sg[64];
    float St[64];
#pragma unroll
    for (int d = 0; d < 64; ++d) St[d] = 0.f;
    for (int t = 0; t < NMETA + S; ++t) {
        const int row = (t < NMETA) ? (M + t) : (b * S + (t - NMETA));
        if (v < 64) { sq[v] = (t < NMETA) ? 0.f : bf2f(QG[(size_t)row * 256 + h * 64 + v]); sk[v] = bf2f(KG[(size_t)row * 256 + h * 64 + v]); sg[v] = expf(GK[(size_t)row * 256 + h * 64 + v]); }
        __syncthreads();
        const float vv = bf2f(VG[(size_t)row * 512 + h * 128 + v]);
        float acc = 0.f;
#pragma unroll
        for (int d = 0; d < 64; ++d) { St[d] = sg[d] * St[d] + sk[d] * vv; acc += sq[d] * St[d]; }
        if (t >= NMETA) O[(size_t)row * 512 + h * 128 + v] = acc;
        __syncthreads();
    }
}
__global__ void __launch_bounds__(128) s_gla_out(const float* __restrict__ O, const bf16_t* __restrict__ RG, const float* __restrict__ w, bf16_t* __restrict__ OG) {
    const int m = blockIdx.x, h = blockIdx.y, v = threadIdx.x;
    __shared__ float red[2];
    const float x = O[(size_t)m * 512 + h * 128 + v];
    float s = x * x;
#pragma unroll
    for (int of = 1; of < 64; of <<= 1) s += __shfl_xor(s, of);
    if ((v & 63) == 0) red[v >> 6] = s;
    __syncthreads();
    const float r = rsqrtf((red[0] + red[1]) / 128.f + EPS);
    OG[(size_t)m * 512 + h * 128 + v] = (bf16_t)f2bf(x * r * w[v] * bf2f(RG[(size_t)m * 512 + h * 128 + v]));
}
__global__ void __launch_bounds__(256) s_moe(const float* __restrict__ norm2_w, const float* __restrict__ rg, const float* __restrict__ re,
                                             const float* __restrict__ wg, const float* __restrict__ wu, const float* __restrict__ wd, float* __restrict__ out) {
    const int t = blockIdx.x, tid = threadIdx.x;
    __shared__ float xn[D]; __shared__ float red[256]; __shared__ float logits[36]; __shared__ float hid[FF]; __shared__ int sel[3]; __shared__ float selw[2];
    float* hr = out + (size_t)t * D;
    float hv4[4]; float s = 0.f;
#pragma unroll
    for (int j = 0; j < 4; ++j) { hv4[j] = hr[tid + 256 * j]; s += hv4[j] * hv4[j]; }
    red[tid] = s; __syncthreads();
    for (int o = 128; o > 0; o >>= 1) { if (tid < o) red[tid] += red[tid + o]; __syncthreads(); }
    const float r = rsqrtf(red[0] / (float)D + EPS);
#pragma unroll
    for (int j = 0; j < 4; ++j) xn[tid + 256 * j] = hv4[j] * r * norm2_w[tid + 256 * j];
    __syncthreads();
    if (tid < 36) {
        float a = 0.f;
        if (tid < 4) { for (int d = 0; d < D; ++d) a += xn[d] * rg[(size_t)d * NG + tid]; }
        else { const int g = (tid - 4) >> 3, e = (tid - 4) & 7; for (int d = 0; d < D; ++d) a += xn[d] * re[((size_t)g * D + d) * EPG + e]; }
        logits[tid] = a;
    }
    __syncthreads();
    if (tid == 0) {
        int g = 0; float mx = logits[0];
        for (int i = 1; i < NG; ++i) if (logits[i] > mx) { mx = logits[i]; g = i; }
        float den = 0.f; for (int i = 0; i < NG; ++i) den += expf(logits[i] - mx);
        const float gw = 1.f / den;
        const float* el = logits + 4 + g * 8;
        int e1 = 0; float v1 = el[0];
        for (int i = 1; i < EPG; ++i) if (el[i] > v1) { v1 = el[i]; e1 = i; }
        int e2 = -1; float v2 = -3.0e38f;
        for (int i = 0; i < EPG; ++i) if (i != e1 && el[i] > v2) { v2 = el[i]; e2 = i; }
        const float p2 = expf(v2 - v1), dn = 1.f + p2;
        sel[0] = g; sel[1] = e1; sel[2] = e2; selw[0] = gw / dn; selw[1] = gw * p2 / dn;
    }
    __syncthreads();
    float y[4] = {0.f, 0.f, 0.f, 0.f};
    const int g = sel[0];
    for (int kk = 0; kk < 2; ++kk) {
        const int e = sel[1 + kk]; const float cw = selw[kk];
        const float* pg = wg + ((size_t)(g * EPG + e) * D) * FF + tid;
        const float* pu = wu + ((size_t)(g * EPG + e) * D) * FF + tid;
        float ag = 0.f, au = 0.f;
        for (int d = 0; d < D; ++d) { const float xv = xn[d]; ag += xv * pg[(size_t)d * FF]; au += xv * pu[(size_t)d * FF]; }
        __syncthreads();
        hid[tid] = silu_f(ag) * au * cw;
        __syncthreads();
        const float* pd = wd + ((size_t)(g * EPG + e) * FF) * D;
        for (int f = 0; f < FF; ++f) { const float hv = hid[f];
#pragma unroll
            for (int j = 0; j < 4; ++j) y[j] += hv * pd[(size_t)f * D + tid + 256 * j]; }
    }
#pragma unroll
    for (int j = 0; j < 4; ++j) hr[tid + 256 * j] = hv4[j] + y[j];
}
__global__ void __launch_bounds__(256) s_moe_hid(const unsigned* __restrict__ gcnt, const int* __restrict__ EL, const float* __restrict__ EW, const bf16_t* __restrict__ XN2,
                                                 const float* __restrict__ wg, const float* __restrict__ wu, bf16_t* __restrict__ HID) {
    __shared__ float xn[D]; __shared__ int s_e, s_pos;
    const int tid = threadIdx.x;
    if (tid == 0) { int idx = blockIdx.x, e = 0; while (e < 31 && idx >= (int)gcnt[e]) { idx -= (int)gcnt[e]; ++e; } s_e = e; s_pos = idx; }
    __syncthreads();
    const int e = s_e, pos = s_pos;
    if (pos >= (int)gcnt[e]) return;
    const int ent = EL[(size_t)e * 16384 + pos], token = ent & 0xffff, slot = ent >> 16; const float cw = EW[(size_t)e * 16384 + pos];
    for (int c = tid; c < D; c += 256) xn[c] = bf2f(XN2[(size_t)token * D + c]);
    __syncthreads();
    const float* pg = wg + (size_t)e * D * FF + tid; const float* pu = wu + (size_t)e * D * FF + tid;
    float ag = 0.f, au = 0.f;
    for (int d = 0; d < D; ++d) { const float xv = xn[d]; ag += xv * pg[(size_t)d * FF]; au += xv * pu[(size_t)d * FF]; }
    HID[(size_t)token * 512 + slot * 256 + tid] = (bf16_t)f2bf(silu_f(ag) * au * cw);
}
__global__ void __launch_bounds__(256) s_moe_out(const int* __restrict__ TI, const bf16_t* __restrict__ HID, const float* __restrict__ wd, float* __restrict__ out) {
    __shared__ float hid[512];
    const int t = blockIdx.x, tid = threadIdx.x; const int ti = TI[t], ge_lo = ti & 0xff, ge_hi = (ti >> 8) & 0xff;
    hid[tid] = bf2f(HID[(size_t)t * 512 + tid]); hid[256 + tid] = bf2f(HID[(size_t)t * 512 + 256 + tid]);
    __syncthreads();
    float y[4] = {0.f, 0.f, 0.f, 0.f};
    const float* p0 = wd + (size_t)ge_lo * FF * D; const float* p1 = wd + (size_t)ge_hi * FF * D;
    for (int f = 0; f < FF; ++f) { const float a = hid[f], b = hid[256 + f];
#pragma unroll
        for (int j = 0; j < 4; ++j) y[j] += a * p0[(size_t)f * D + tid + 256 * j] + b * p1[(size_t)f * D + tid + 256 * j]; }
#pragma unroll
    for (int j = 0; j < 4; ++j) out[(size_t)t * D + tid + 256 * j] += y[j];
}
struct Args { const float* in[19]; float* out; unsigned char* ws; int ph_lo, ph_hi, li, pad; };
constexpr int N_PHASES = 10;

__global__ void __launch_bounds__(NWAVES * 64, 2) mk_fwd(Args args) {
    extern __shared__ __attribute__((aligned(16))) unsigned char lds[];
    Frame F;
    F.lds = (LAS unsigned char*)lds;
    F.MISC = (volatile LAS unsigned*)(F.lds + MISC_OFF);
    F.tid = threadIdx.x; F.lane = F.tid & 63; F.wave = __builtin_amdgcn_readfirstlane(F.tid >> 6);
    F.G = gridDim.x; { const int bx = blockIdx.x; F.vcu = (F.G % 8 == 0) ? (bx % 8) * (F.G / 8) + bx / 8 : bx; }
    unsigned char* ws = args.ws; F.ws = ws; F.out = args.out;
    F.ctl = (gu32*)(ws + WS_CTL);
    F.x = args.in[0]; F.meta = args.in[1]; F.norm1_w = args.in[2]; F.w_in = args.in[3]; F.q_norm_w = args.in[4]; F.k_norm_w = args.in[5]; F.sinks = args.in[6]; F.gate_up = args.in[7];
    F.gate_bias = args.in[8]; F.gla_norm_w = args.in[9]; F.w_ab = args.in[10]; F.w_gb = args.in[11]; F.w_out = args.in[12]; F.norm2_w = args.in[13]; F.r_g = args.in[14]; F.r_e = args.in[15];
    F.e_wg = args.in[16]; F.e_wu = args.in[17]; F.e_wd = args.in[18];
    for (int u = F.tid; u < (LDS_BYTES - LDSCTL_OFF) / 4; u += NWAVES * 64) ((LAS unsigned*)(F.lds + LDSCTL_OFF))[u] = 0u;
    __syncthreads();
    XcdBarrier bar = xcd_barrier_post((unsigned*)(F.ctl + CW_BAR) + args.li * XCD_BAR_WORDS, F.MISC + 8);
    const int lo = args.ph_lo, hi = args.ph_hi;
#ifdef DIAG_K
    const unsigned long long dg_t0 = __builtin_amdgcn_s_memrealtime(); unsigned long long dg_a = dg_t0, dg_b = dg_t0;
#define DG_STAMP(k) do { if ((k) == DIAG_K0 - 1) dg_a = __builtin_amdgcn_s_memrealtime(); if ((k) == DIAG_K) dg_b = __builtin_amdgcn_s_memrealtime(); } while (0)
#else
#define DG_STAMP(k) do {} while (0)
#endif
#define IN(k) (lo <= (k) && (k) < hi)
#define BOTH(k) (IN(k) && (k) + 1 < hi)
#define GRID_BAR() xcd_barrier(bar)
#define PH_END(k) do { if (BOTH(k)) GRID_BAR(); DG_STAMP(k); } while (0)

    if (IN(0)) { p0_prologue(F); p0_router_weights(F); PH_END(0); }

    if (IN(1)) {
        pg8::Gemm g{(const bf16_t*)(ws + WS_XN), (const bf16_t*)(ws + WS_WPT), MX, NP, D, D, D};
        pg8::ProjOrder So{F.G, (int)blockIdx.x};
        pg8::EpiProj E{(bf16_t*)(ws + WS_QA), (bf16_t*)(ws + WS_KA), (bf16_t*)(ws + WS_VA), (bf16_t*)(ws + WS_QG), (bf16_t*)(ws + WS_KG), (bf16_t*)(ws + WS_VG), (bf16_t*)(ws + WS_RG),
                       (bf16_t*)F.out, (bf16_t*)F.out + (size_t)M * 1024, (float*)(ws + WS_GK), F.q_norm_w, F.k_norm_w, F.gate_bias, (const float*)(ws + WS_ROPE)};
        pg8::gemm_phase<pg8::EpiProj, pg8::ProjOrder, true, true>(F.lds + RING_OFF, g, So, E);
        if (F.G == 256) { if (blockIdx.x >= 133) expert_weight_items(F, ((int)blockIdx.x - 133) * NWAVES + F.wave, 123 * NWAVES, 0, EXP_ITEMS_GU); }
        else expert_weight_items(F, (int)blockIdx.x * NWAVES + F.wave, F.G * NWAVES, 0, EXP_ITEMS_GU);
        PH_END(1);
    }

    if (IN(2)) {
        DG_MARK(F, 4);
        const int team = F.tid >> 8;
        GlaIn gc, gn; int u = (int)blockIdx.x + team * F.G; int uu = (u < 1028) ? u : -1;
        gla_a_load(F, uu, gc);
        attn_phase(F); DG_MARK(F, 5);
        for (int ub = blockIdx.x; ub < 1028; ub += 2 * F.G) {
            const int un = u + 2 * F.G, unn = (un < 1028) ? un : -1;
            gla_a_load(F, unn, gn);
            gla_a_unit(F, uu, gc); gc = gn; u = un; uu = unn;
        }
        DG_MARK(F, 7); PH_END(2);
    }
    if (IN(3)) { gla_scan_phase(F); PH_END(3); }
    if (IN(4)) { gla_c_phase(F); PH_END(4); }

    if (IN(5)) {
        pg8::Gemm g{(const bf16_t*)(ws + WS_A2), (const bf16_t*)(ws + WS_WBT), M, D, 512, D, D};
        pg8::MergeOrder So{(int)blockIdx.x};
        pg8::EpiMerge E{(const bf16_t*)F.out, (const bf16_t*)F.out + (size_t)M * 1024, (bf16_t*)(ws + WS_MG)};
        pg8::gemm_phase<pg8::EpiMerge, pg8::MergeOrder, true, true>(F.lds + RING_OFF, g, So, E);
        PH_END(5);
    }

    if (IN(6)) {
        pg8::Gemm g{(const bf16_t*)(ws + WS_MG), (const bf16_t*)(ws + WS_WOT), M, D, D, D, D};
        pg8::StaticOrder So; So.init(M, D, F.G, (int)blockIdx.x);
        pg8::EpiOut E{F.x, F.out};
        pg8::gemm_phase<pg8::EpiOut, pg8::StaticOrder, false, true>(F.lds + RING_OFF, g, So, E);
        PH_END(6);
    }
    if (IN(7)) { router_phase(F); PH_END(7); }
    if (IN(8)) { moe1_phase(F); PH_END(8); }
    if (IN(9)) { moe2_phase(F); DG_STAMP(9); }
#ifdef DIAG_K
#ifdef DIAG_MA
    __syncthreads(); dg_a = F.MISC[16 + DIAG_MA]; dg_b = F.MISC[16 + DIAG_MB];
#endif
    if (blockIdx.x == 0) { const unsigned long long tend = __builtin_amdgcn_s_memrealtime() + 4ull * ((dg_b - dg_a) & 0xffffffffull); while (__builtin_amdgcn_s_memrealtime() < tend) __builtin_amdgcn_s_sleep(8); }
#endif
#undef IN
#undef BOTH
#undef GRID_BAR
}

extern "C" void kernel_launch(void* const* d_in, const int* in_sizes, int n_in, void* d_out, int out_size, void* d_ws, size_t ws_size, hipStream_t stream) {
    static int grid = 0;
    if (grid == 0) {
        if (n_in != 19 || out_size != M * D || ws_size < WS_END) { fprintf(stderr, "kernel_launch: unexpected shapes (n_in %d out %d ws %zu)\n", n_in, out_size, ws_size); grid = -1; return; }
        int dev = 0, cus = 0;
        if (hipGetDevice(&dev) != hipSuccess || hipDeviceGetAttribute(&cus, hipDeviceAttributeMultiprocessorCount, dev) != hipSuccess) { grid = -1; return; }
        if (hipFuncSetAttribute((const void*)mk_fwd, hipFuncAttributeMaxDynamicSharedMemorySize, LDS_BYTES) != hipSuccess) { fprintf(stderr, "kernel_launch: hipFuncSetAttribute failed\n"); grid = -1; return; }
        int per_cu = 0;
        if (hipOccupancyMaxActiveBlocksPerMultiprocessor(&per_cu, (const void*)mk_fwd, NWAVES * 64, LDS_BYTES) != hipSuccess || per_cu < 1) fprintf(stderr, "kernel_launch: occupancy query reports %d\n", per_cu);
        (void)hipGetLastError();
        grid = cus >= 256 ? 256 : cus;
        if (grid != 256) fprintf(stderr, "kernel_launch: %d CUs (built for 256)\n", grid);
    }
    if (grid < 0) return;
    (void)hipMemsetAsync((char*)d_ws + WS_CTL, 0, CTL_ZERO_BYTES, stream);
    Args a{};
    for (int i = 0; i < 19; ++i) a.in[i] = (const float*)d_in[i];
    a.out = (float*)d_out; a.ws = (unsigned char*)d_ws;
    unsigned char* ws = (unsigned char*)d_ws;
    a.ph_lo = 0; a.ph_hi = 10; a.li = 0;
    hipLaunchKernelGGL(mk_fwd, dim3(grid), dim3(NWAVES * 64), LDS_BYTES, stream, a);
}
```
